# Optimizing an MI355X kernel written in HIP

```python
import jax
import jax.numpy as jnp
from jax import lax
import numpy as np

D_MODEL = 1024
BATCH = 32
SEQ = 256
DEPTH = 2
DEC_BATCH = 2
DEC_SEQ = 4096
PAST_LEN = 512

GRID_W = 64
H_A = 4
Q_RANK = 192
KV_RANK = 128
NOPE_A = 64
ROPE_A = 32
V_A = 64
H_B = 4
P_B = 64
G_B = 2
N_B = 64
D_CONV = 5
SSD_CHUNK = 128
D_B = H_B * P_B
CONV_CH = D_B + 2 * G_B * N_B
H_C = 4
K_C = 64
V_C = 64
HGRN_CHUNK = 16
D_C = H_C * V_C
H_D = 4
KV_D = 2
G_D = H_D // KV_D
HD_D = 64
WINDOW = 128
ATTN_BLOCK = 128
ROPE_BASE = 10000.0
D_MIX = H_A * V_A + D_B + D_C + H_D * HD_D
D_FF = 2816
N_SUB = 3
ALPHA = (2 * DEPTH) ** 0.25
BETA = (8 * DEPTH) ** -0.25
EPS = 1e-6
F_MIN = 1e-6
IN_SIZES = (Q_RANK, KV_RANK, ROPE_A,
            D_B, CONV_CH, 2 * H_B,
            H_C * K_C, 2 * H_C * K_C, D_C, D_C,
            H_D * HD_D, KV_D * HD_D, KV_D * HD_D)
D_IN = sum(IN_SIZES)
IN_SPLITS = tuple(int(v) for v in np.cumsum(IN_SIZES)[:-1])
F32 = jnp.float32
NEG = -1e30

kernel_name = 'hybrid_diffusion_prefix_trunk_step'


def rms_norm(x, g):
    xf = x.astype(F32)
    y = xf * lax.rsqrt(jnp.mean(xf * xf, axis=-1, keepdims=True) + EPS)
    return (y * g.astype(F32)).astype(x.dtype)


def layer_norm(x, g, b):
    xf = x.astype(F32)
    xc = xf - jnp.mean(xf, axis=-1, keepdims=True)
    var = jnp.mean(xc * xc, axis=-1, keepdims=True)
    return (xc * lax.rsqrt(var + EPS) * g.astype(F32) + b.astype(F32)).astype(x.dtype)


def rope_1d(x, pos):
    half = x.shape[-1] // 2
    inv = ROPE_BASE ** (-jnp.arange(half, dtype=F32) / half)
    ang = pos[:, None] * inv[None, :]
    cos = jnp.cos(ang)[None, :, None, :]
    sin = jnp.sin(ang)[None, :, None, :]
    x1 = x[..., :half].astype(F32)
    x2 = x[..., half:].astype(F32)
    return jnp.concatenate([x1 * cos - x2 * sin, x1 * sin + x2 * cos], axis=-1)


def axial_rope(x):
    t_len = x.shape[1]
    rows = t_len // GRID_W
    row = jnp.repeat(jnp.arange(rows, dtype=F32), GRID_W)
    col = (jnp.arange(t_len) % GRID_W).astype(F32)
    r = x.shape[-1] // 2
    return jnp.concatenate([rope_1d(x[..., :r], row), rope_1d(x[..., r:], col)], axis=-1).astype(x.dtype)


def sink_softmax(s, sink):
    if sink is None:
        return jax.nn.softmax(s, axis=-1)
    sk = sink.astype(F32)[:, :, None]
    m = jnp.maximum(jnp.max(s, axis=-1), sk)
    e = jnp.exp(s - m[..., None])
    den = jnp.sum(e, axis=-1) + jnp.exp(sk - m)
    return e / den[..., None]


def dense_attention(q, k, v, sink):
    B, Tq, Hk, G, Dq = q.shape
    scale = Dq ** -0.5
    qb = jnp.moveaxis(q.reshape(B, Tq // ATTN_BLOCK, ATTN_BLOCK, Hk, G, Dq), 1, 0)

    def one_block(q_blk):
        s = jnp.einsum('bqhgd,bkhd->bhgqk', q_blk, k, preferred_element_type=F32) * scale
        p = sink_softmax(s, sink)
        return jnp.einsum('bhgqk,bkhd->bqhgd', p.astype(v.dtype), v)

    o = lax.map(one_block, qb)
    return jnp.moveaxis(o, 0, 1).reshape(B, Tq, Hk, G, v.shape[-1])


def banded_attention(q, k, v, kc, vc, sink):
    B, T, Hk, G, D = q.shape
    W = WINDOW
    nb = T // W
    scale = D ** -0.5
    qb = q.reshape(B, nb, W, Hk, G, D)
    pad = ((0, 0), (W, W), (0, 0), (0, 0))
    kp = jnp.pad(k, pad).reshape(B, nb + 2, W, Hk, D)
    vp = jnp.pad(v, pad).reshape(B, nb + 2, W, Hk, D)
    kb = jnp.concatenate([kp[:, :-2], kp[:, 1:-1], kp[:, 2:]], axis=2)
    vb = jnp.concatenate([vp[:, :-2], vp[:, 1:-1], vp[:, 2:]], axis=2)
    qi = jnp.arange(W)[:, None]
    kj = jnp.arange(3 * W)[None, :]
    band = jnp.abs(kj - W - qi) <= WINDOW
    seg_blk = jnp.arange(nb)[:, None] + jnp.arange(3)[None, :] - 1
    valid = jnp.repeat((seg_blk >= 0) & (seg_blk < nb), W, axis=1)
    mask = band[None] & valid[:, None, :]
    s_lat = jnp.einsum('bnqhgd,bnkhd->bnhgqk', qb, kb, preferred_element_type=F32) * scale
    s_lat = jnp.where(mask[None, :, None, None], s_lat, NEG)
    s_ctx = jnp.einsum('bnqhgd,bkhd->bnhgqk', qb, kc, preferred_element_type=F32) * scale
    p = sink_softmax(jnp.concatenate([s_lat, s_ctx], axis=-1), sink)
    o = (jnp.einsum('bnhgqk,bnkhd->bnqhgd', p[..., :3 * W].astype(vb.dtype), vb)
         + jnp.einsum('bnhgqk,bkhd->bnqhgd', p[..., 3 * W:].astype(vc.dtype), vc))
    return o.reshape(B, T, Hk, G, D)


def centred_dwconv(x, w, b):
    y = lax.conv_general_dilated(x, w[:, None, :].astype(x.dtype), window_strides=(1,),
                                 padding=((D_CONV // 2, D_CONV // 2),),
                                 dimension_numbers=('NWC', 'WIO', 'NWC'),
                                 feature_group_count=x.shape[-1])
    return y + b.astype(x.dtype)


def masked_decay(diff, causal):
    return jnp.where(causal, jnp.exp(jnp.where(causal, diff, 0.0)), 0.0)


def ssd_scan(x, dt, a, bm, cm, d_skip, s0):
    B, T, H, P = x.shape
    Q = SSD_CHUNK
    nc = T // Q
    ch = lambda t: t.astype(F32).reshape(B, nc, Q, *t.shape[2:])
    xc, dtc, bc, cc = ch(x), ch(dt), ch(bm), ch(cm)
    cum = jnp.cumsum(dtc * a.astype(F32), axis=2)
    xdt = xc * dtc[..., None]
    causal = jnp.tril(jnp.ones((Q, Q), bool))[:, :, None]
    diff = cum[:, :, :, None] - cum[:, :, None, :]
    seg = masked_decay(diff, causal)
    scores = jnp.einsum('bcihn,bcjhn->bcijh', cc, bc) * seg
    y_intra = jnp.einsum('bcijh,bcjhp->bcihp', scores, xdt)
    last = cum[:, :, -1:]
    chunk_state = jnp.einsum('bcjhn,bcjhp->bchpn', bc * jnp.exp(last - cum)[..., None], xdt)
    chunk_decay = jnp.exp(last[:, :, 0])

    def step(s, inp):
        cs, cd = inp
        return cd[..., None, None] * s + cs, s

    s_fin, s_in = lax.scan(step, s0.astype(F32),
                           (jnp.moveaxis(chunk_state, 1, 0), jnp.moveaxis(chunk_decay, 1, 0)))
    s_in = jnp.moveaxis(s_in, 0, 1)
    y_inter = jnp.einsum('bcihn,bchpn->bcihp', cc * jnp.exp(cum)[..., None], s_in)
    y = (y_intra + y_inter).reshape(B, T, H, P) + x.astype(F32) * d_skip.astype(F32)[:, None]
    return y.astype(x.dtype), s_fin.astype(x.dtype)


def gla_scan(q, k, v, log_f, s0):
    B, T, H, K = q.shape
    Q = HGRN_CHUNK
    nc = T // Q
    ch = lambda t: t.astype(F32).reshape(B, nc, Q, *t.shape[2:])
    qc, kc, vc, lf = ch(q), ch(k), ch(v), ch(log_f)
    cum = jnp.cumsum(lf, axis=2)
    causal = jnp.tril(jnp.ones((Q, Q), bool))[:, :, None, None]
    diff = cum[:, :, :, None] - cum[:, :, None, :]
    dec = masked_decay(diff, causal)
    att = jnp.einsum('bcijhk,bcjhk->bcijh', dec * qc[:, :, :, None], kc)
    o_intra = jnp.einsum('bcijh,bcjhv->bcihv', att, vc)
    last = cum[:, :, -1:]
    chunk_state = jnp.einsum('bcjhk,bcjhv->bchkv', kc * jnp.exp(last - cum), vc)
    chunk_decay = jnp.exp(last[:, :, 0])

    def step(s, inp):
        cs, cd = inp
        return cd[..., None] * s + cs, s

    s_fin, s_in = lax.scan(step, s0.astype(F32),
                           (jnp.moveaxis(chunk_state, 1, 0), jnp.moveaxis(chunk_decay, 1, 0)))
    s_in = jnp.moveaxis(s_in, 0, 1)
    o_inter = jnp.einsum('bcihk,bchkv->bcihv', qc * jnp.exp(cum), s_in)
    o = (o_intra + o_inter).reshape(B, T, H, v.shape[-1])
    return o.astype(v.dtype), s_fin.astype(v.dtype)


def flip_t(t):
    return jnp.flip(t, axis=1)


def mla_expand(ckv_n, kr, w_ukv):
    B, T, _ = ckv_n.shape
    kv = (ckv_n @ w_ukv).reshape(B, T, H_A, NOPE_A + V_A)
    k = jnp.concatenate([kv[..., :NOPE_A], jnp.broadcast_to(kr, (B, T, H_A, ROPE_A)).astype(kv.dtype)], axis=-1)
    return k, kv[..., NOPE_A:]


def ssd_mixer(z, xbc, dt_raw, p, s0):
    B, T, _ = z.shape
    xbc = jax.nn.silu(centred_dwconv(xbc, p['ssd_conv_w'], p['ssd_conv_b']))
    xs, bm, cm = jnp.split(xbc, [D_B, D_B + G_B * N_B], axis=-1)
    xs = xs.reshape(B, T, H_B, P_B)
    rep = H_B // G_B
    bm = jnp.repeat(bm.reshape(B, T, G_B, N_B), rep, axis=2)
    cm = jnp.repeat(cm.reshape(B, T, G_B, N_B), rep, axis=2)
    dt = jax.nn.softplus(dt_raw.reshape(B, T, 2, H_B).astype(F32) + p['ssd_dt_bias'].astype(F32))
    a = -jnp.exp(p['ssd_a_log'].astype(F32))
    d = p['ssd_d']
    y_f, s_f = ssd_scan(xs, dt[:, :, 0], a[0], bm, cm, d[0], s0[:, 0])
    y_b, s_b = ssd_scan(flip_t(xs), flip_t(dt[:, :, 1]), a[1], flip_t(bm), flip_t(cm), d[1], s0[:, 1])
    y = (y_f + flip_t(y_b)) * jax.nn.silu(z.reshape(B, T, H_B, P_B))
    y = rms_norm(y, p['ssd_norm'].reshape(H_B, P_B))
    return y.reshape(B, T, D_B), jnp.stack([s_f, s_b], axis=1)


def hgrn_mixer(q, f_raw, i_in, g, p, s0):
    B, T, _ = q.shape
    fr = f_raw.reshape(B, T, 2, H_C, K_C).astype(F32)
    lb = p['hgrn_lb'].astype(F32).reshape(2, H_C, K_C)
    f = lb + (1.0 - lb) * jax.nn.sigmoid(fr)
    log_f = jnp.log(jnp.maximum(f, F_MIN))
    key = (1.0 - lb) * jax.nn.sigmoid(-fr)
    qh = q.reshape(B, T, H_C, K_C)
    vh = i_in.reshape(B, T, H_C, V_C)
    o_f, s_f = gla_scan(qh, key[:, :, 0], vh, log_f[:, :, 0], s0[:, 0])
    o_b, s_b = gla_scan(flip_t(qh), flip_t(key[:, :, 1]), flip_t(vh), flip_t(log_f[:, :, 1]), s0[:, 1])
    o = rms_norm(o_f + flip_t(o_b), p['hgrn_norm'].reshape(H_C, V_C)) * jax.nn.silu(g.reshape(B, T, H_C, V_C))
    return o.reshape(B, T, D_C), jnp.stack([s_f, s_b], axis=1)


def token_mixing(h, p, ctx):
    B, T, _ = h.shape
    latent = ctx is not None
    (a_cq, a_ckv, a_kr, b_z, b_xbc, b_dt, c_q, c_f, c_i, c_g, d_q, d_k, d_v) = jnp.split(
        h @ p['w_in'], IN_SPLITS, axis=-1)

    q_a = (rms_norm(a_cq, p['mla_q_norm']) @ p['mla_w_uq']).reshape(B, T, H_A, NOPE_A + ROPE_A)
    ckv_n = rms_norm(a_ckv, p['mla_kv_norm'])
    kr = a_kr[:, :, None, :]
    if latent:
        q_a = jnp.concatenate([q_a[..., :NOPE_A], axial_rope(q_a[..., NOPE_A:])], axis=-1)
        kr = axial_rope(kr)
    k_a, v_a = mla_expand(ckv_n, kr, p['mla_w_ukv'])
    if latent:
        k_c, v_c = mla_expand(ctx[0], ctx[1][:, :, None, :], p['mla_w_ukv'])
        k_a = jnp.concatenate([k_a, k_c], axis=1)
        v_a = jnp.concatenate([v_a, v_c], axis=1)
    o_a = dense_attention(q_a[:, :, :, None, :], k_a, v_a, None).reshape(B, T, H_A * V_A)

    s0_b = ctx[2] if latent else jnp.zeros((B, 2, H_B, P_B, N_B), h.dtype)
    o_b, st_b = ssd_mixer(b_z, b_xbc, b_dt, p, s0_b)

    s0_c = ctx[3] if latent else jnp.zeros((B, 2, H_C, K_C, V_C), h.dtype)
    o_c, st_c = hgrn_mixer(c_q, c_f, c_i, c_g, p, s0_c)

    q_d = d_q.reshape(B, T, H_D, HD_D)
    k_d = d_k.reshape(B, T, KV_D, HD_D)
    v_d = d_v.reshape(B, T, KV_D, HD_D)
    sink = p['gqa_sink'].reshape(KV_D, G_D)
    if latent:
        o_d = banded_attention(axial_rope(q_d).reshape(B, T, KV_D, G_D, HD_D), axial_rope(k_d), v_d,
                               ctx[4], ctx[5], sink)
    else:
        o_d = dense_attention(q_d.reshape(B, T, KV_D, G_D, HD_D), k_d, v_d, sink)
    o_d = o_d.reshape(B, T, H_D * HD_D)

    out = jnp.concatenate([o_a, o_b, o_c, o_d], axis=-1) @ p['w_out']
    state = None if latent else (ckv_n, a_kr, st_b, st_c, k_d, v_d)
    return out, state


def swiglu(h, w_gu, w_down):
    gate, up = jnp.split(h @ w_gu, 2, axis=-1)
    return (jax.nn.silu(gate) * up) @ w_down


def modulate(x, shift, scale):
    return x * (1 + scale) + shift


def trunk_layer(x, mod, p, ctx):
    shift, scale, gate = mod[:, :, :, 0], mod[:, :, :, 1], mod[:, :, :, 2]
    h = modulate(x, shift[:, :, 0], scale[:, :, 0])
    x = layer_norm(ALPHA * x + 0.5 * gate[:, :, 0] * swiglu(h, p['ffn_w_gu'][0], p['ffn_w_down'][0]),
                   p['ln_g'][0], p['ln_b'][0])
    h = modulate(x, shift[:, :, 1], scale[:, :, 1])
    u, state = token_mixing(h, p, ctx)
    x = layer_norm(ALPHA * x + gate[:, :, 1] * u, p['ln_g'][1], p['ln_b'][1])
    h = modulate(x, shift[:, :, 2], scale[:, :, 2])
    x = layer_norm(ALPHA * x + 0.5 * gate[:, :, 2] * swiglu(h, p['ffn_w_gu'][1], p['ffn_w_down'][1]),
                   p['ln_g'][2], p['ln_b'][2])
    return x, state


def setup_inputs(seed: int = 0) -> dict:
    key = jax.random.key(seed)
    ks = iter(jax.random.split(key, 48))

    def nrm(shape, scale):
        return scale * jax.random.normal(next(ks), shape, F32)

    dt0 = jnp.exp(jax.random.uniform(next(ks), (DEPTH, 2, H_B), F32, np.log(1e-3), np.log(1e-1)))
    dt_bias = dt0 + jnp.log(-jnp.expm1(-dt0))
    a_log = jnp.log(jax.random.uniform(next(ks), (DEPTH, 2, H_B), F32, 1.0, 16.0))
    return {
        'x_prompt': nrm((BATCH, SEQ, D_MODEL), 1.0),
        'x_sample': nrm((DEC_BATCH, DEC_SEQ, D_MODEL), 1.0),
        'cache_a_ckv': nrm((DEC_BATCH, DEPTH, PAST_LEN, KV_RANK), 1.0),
        'cache_a_krope': nrm((DEC_BATCH, DEPTH, PAST_LEN, ROPE_A), 1.0),
        'state_b_ssm': nrm((DEC_BATCH, DEPTH, 2, H_B, P_B, N_B), 0.5),
        'state_c_hgrn': nrm((DEC_BATCH, DEPTH, 2, H_C, K_C, V_C), 0.5),
        'cache_d_k': nrm((DEC_BATCH, DEPTH, PAST_LEN, KV_D, HD_D), 1.0),
        'cache_d_v': nrm((DEC_BATCH, DEPTH, PAST_LEN, KV_D, HD_D), 1.0),
        'c': nrm((DEC_BATCH, D_MODEL), 1.0),
        'c_ctx': nrm((D_MODEL,), 1.0),
        'w_mod': nrm((DEPTH, D_MODEL, N_SUB * 3 * D_MODEL), 0.5 * D_MODEL ** -0.5),
        'b_mod': nrm((DEPTH, N_SUB * 3 * D_MODEL), 0.02),
        'ln_g': 1.0 + nrm((DEPTH, N_SUB, D_MODEL), 0.02),
        'ln_b': nrm((DEPTH, N_SUB, D_MODEL), 0.02),
        'ffn_w_gu': nrm((DEPTH, 2, D_MODEL, 2 * D_FF), BETA * D_MODEL ** -0.5),
        'ffn_w_down': nrm((DEPTH, 2, D_FF, D_MODEL), BETA * D_FF ** -0.5),
        'w_in': nrm((DEPTH, D_MODEL, D_IN), D_MODEL ** -0.5),
        'w_out': nrm((DEPTH, D_MIX, D_MODEL), BETA * D_MIX ** -0.5),
        'mla_q_norm': 1.0 + nrm((DEPTH, Q_RANK), 0.02),
        'mla_kv_norm': 1.0 + nrm((DEPTH, KV_RANK), 0.02),
        'mla_w_uq': nrm((DEPTH, Q_RANK, H_A * (NOPE_A + ROPE_A)), Q_RANK ** -0.5),
        'mla_w_ukv': nrm((DEPTH, KV_RANK, H_A * (NOPE_A + V_A)), KV_RANK ** -0.5),
        'ssd_conv_w': nrm((DEPTH, D_CONV, CONV_CH), D_CONV ** -0.5),
        'ssd_conv_b': nrm((DEPTH, CONV_CH), 0.02),
        'ssd_a_log': a_log,
        'ssd_dt_bias': dt_bias,
        'ssd_d': 1.0 + nrm((DEPTH, 2, H_B), 0.02),
        'ssd_norm': 1.0 + nrm((DEPTH, D_B), 0.02),
        'hgrn_lb_logits': nrm((DEPTH, 2, H_C * K_C), 0.1),
        'hgrn_norm': 1.0 + nrm((DEPTH, D_C), 0.02),
        'gqa_sink': nrm((DEPTH, H_D), 0.5),
    }


def reference(x_prompt, x_sample, cache_a_ckv, cache_a_krope, state_b_ssm, state_c_hgrn,
              cache_d_k, cache_d_v, c, c_ctx, w_mod, b_mod, ln_g, ln_b, ffn_w_gu, ffn_w_down,
              w_in, w_out, mla_q_norm, mla_kv_norm, mla_w_uq, mla_w_ukv, ssd_conv_w, ssd_conv_b,
              ssd_a_log, ssd_dt_bias, ssd_d, ssd_norm, hgrn_lb_logits, hgrn_norm, gqa_sink):
    lb_p = jax.nn.softmax(hgrn_lb_logits.astype(F32), axis=0)
    hgrn_lb = jnp.cumsum(lb_p, axis=0) - lb_p[:1]
    y_p = x_prompt
    y_s = x_sample
    ctx_states = []
    for l in range(DEPTH):
        p = {'w_in': w_in[l], 'w_out': w_out[l], 'ln_g': ln_g[l], 'ln_b': ln_b[l],
             'ffn_w_gu': ffn_w_gu[l], 'ffn_w_down': ffn_w_down[l],
             'mla_q_norm': mla_q_norm[l], 'mla_kv_norm': mla_kv_norm[l],
             'mla_w_uq': mla_w_uq[l], 'mla_w_ukv': mla_w_ukv[l],
             'ssd_conv_w': ssd_conv_w[l], 'ssd_conv_b': ssd_conv_b[l], 'ssd_a_log': ssd_a_log[l],
             'ssd_dt_bias': ssd_dt_bias[l], 'ssd_d': ssd_d[l], 'ssd_norm': ssd_norm[l],
             'hgrn_lb': hgrn_lb[l], 'hgrn_norm': hgrn_norm[l], 'gqa_sink': gqa_sink[l]}
        mod_ctx = (jax.nn.silu(c_ctx) @ w_mod[l] + b_mod[l]).reshape(1, 1, N_SUB, 3, D_MODEL)
        mod_lat = (jax.nn.silu(c) @ w_mod[l] + b_mod[l]).reshape(c.shape[0], 1, N_SUB, 3, D_MODEL)
        y_p, st = trunk_layer(y_p, mod_ctx, p, None)
        ctx_states.append(st)
        ctx = (cache_a_ckv[:, l], cache_a_krope[:, l], state_b_ssm[:, l], state_c_hgrn[:, l],
               cache_d_k[:, l], cache_d_v[:, l])
        y_s, _ = trunk_layer(y_s, mod_lat, p, ctx)
    new_a_ckv = jnp.stack([s[0] for s in ctx_states], axis=1)
    new_a_krope = jnp.stack([s[1] for s in ctx_states], axis=1)
    new_b_ssm = jnp.stack([s[2] for s in ctx_states], axis=1)
    new_c_hgrn = jnp.stack([s[3] for s in ctx_states], axis=1)
    new_d_k = jnp.stack([s[4] for s in ctx_states], axis=1)
    new_d_v = jnp.stack([s[5] for s in ctx_states], axis=1)
    return (y_p, y_s, new_a_ckv, new_a_krope, new_b_ssm, new_c_hgrn, new_d_k, new_d_v)
```

```cpp
#include <hip/hip_runtime.h>
#include <hip/hip_cooperative_groups.h>
#include <cstdio>
namespace cg = cooperative_groups;

typedef unsigned short u16;
using bf16x8 = __attribute__((ext_vector_type(8))) short;
using f32x4 = __attribute__((ext_vector_type(4))) float;
#define DEV __device__ __forceinline__
#define LDS_DECL extern __shared__ __attribute__((aligned(16))) unsigned char lds_raw[]

constexpr int NTH = 512;
constexpr int DM = 1024, DFF = 2816, NGU = 5632, NIN = 2920, NINP = 3072, MTOT = 16384, MP = 8192;
constexpr float ALPHA_F = 1.41421356237309515f;
constexpr float LOG2E = 1.44269504088896341f;
constexpr float EPS_F = 1e-6f;
constexpr int LDS_BYTES = 131072;

constexpr int C_ACQ = 0, C_ACKV = 192, C_AKR = 320, C_BZ = 352, C_BXBC = 608, C_BDT = 1120, C_CQ = 1128, C_CF = 1384,
              C_CI = 1896, C_CG = 2152, C_DQ = 2408, C_DK = 2664, C_DV = 2792;
constexpr size_t O_YP = 0, O_YS = 8388608, O_CKV = 16777216, O_KR = 18874368, O_BSSM = 19398656, O_CH = 21495808,
                 O_DK = 23592960, O_DV = 25690112;
constexpr size_t WS_CTL = 0;
constexpr size_t WS_MOD = 4096;
constexpr size_t WS_WGU = 262144;
constexpr size_t SZ_WGU1 = (size_t)NGU * DM * 2;
constexpr size_t WS_WDN = WS_WGU + 2 * SZ_WGU1;
constexpr size_t SZ_WDN1 = (size_t)DM * DFF * 2;
constexpr size_t WS_WIN = WS_WDN + 2 * SZ_WDN1;
constexpr size_t WS_WOUT = WS_WIN + (size_t)NINP * DM * 2;
constexpr size_t WS_X = WS_WOUT + (size_t)DM * DM * 2;
constexpr size_t WS_H = WS_X + (size_t)MTOT * DM * 4;
constexpr size_t WS_R1 = WS_H + (size_t)MTOT * DM * 2;
constexpr size_t WS_QA = WS_R1 + (size_t)MTOT * NINP * 2;
constexpr int KAROWS = 8192 + 2 * 4608;
constexpr size_t WS_KA = WS_QA + (size_t)MTOT * 384 * 2;
constexpr size_t WS_VA = WS_KA + (size_t)KAROWS * 384 * 2;
constexpr size_t WS_QD = WS_VA + (size_t)KAROWS * 256 * 2;
constexpr size_t WS_KD = WS_QD + (size_t)MTOT * 256 * 2;
constexpr size_t WS_YF = WS_KD + (size_t)MTOT * 128 * 2;
constexpr size_t WS_YB = WS_YF + (size_t)MTOT * 256 * 4;
constexpr size_t WS_OF = WS_YB + (size_t)MTOT * 256 * 4;
constexpr size_t WS_OB = WS_OF + (size_t)MTOT * 256 * 4;
constexpr int NSEG = 16, SEGLEN = 256;
constexpr size_t WS_SSLOC = WS_OB + (size_t)MTOT * 256 * 4;
constexpr size_t WS_GSLOC = WS_SSLOC + (size_t)2 * 4 * 2 * NSEG * 4096 * 4;
constexpr size_t WS_SDEC = WS_GSLOC + (size_t)2 * 4 * 2 * NSEG * 4096 * 4;
constexpr size_t WS_GDEC = WS_SDEC + 4096;
constexpr size_t WS_WUQ = WS_GDEC + (size_t)2 * 4 * 2 * NSEG * 64 * 4;
constexpr size_t WS_WUKV = WS_WUQ + (size_t)384 * 192 * 2;
constexpr size_t WS_END = WS_WUKV + (size_t)512 * 128 * 2;

struct Params {
  const float* in[31];
  float* out;
  unsigned char* ws;
};

typedef const __attribute__((address_space(4))) Params* KParamsPtr;
template <typename T>
DEV T* uni_ptr(T* p) {
  unsigned long long v = (unsigned long long)p;
  unsigned lo = __builtin_amdgcn_readfirstlane((unsigned)v), hi = __builtin_amdgcn_readfirstlane((unsigned)(v >> 32));
  return (T*)(((unsigned long long)hi << 32) | lo);
}
DEV Params getp() {
  Params r;
#if defined(__HIP_DEVICE_COMPILE__)
  KParamsPtr k;
  {
    unsigned long long v = (unsigned long long)__builtin_amdgcn_kernarg_segment_ptr();
    unsigned lo = __builtin_amdgcn_readfirstlane((unsigned)v), hi = __builtin_amdgcn_readfirstlane((unsigned)(v >> 32));
    k = (KParamsPtr)(((unsigned long long)hi << 32) | lo);
  }
#pragma unroll
  for (int i = 0; i < 31; ++i) r.in[i] = k->in[i];
  r.out = k->out;
  r.ws = k->ws;
#else
  r = Params{};
#endif
  return r;
}
DEV float bf2f(u16 u) { return __uint_as_float(((unsigned)u) << 16); }
typedef __attribute__((ext_vector_type(2))) float f32x2_t;
typedef __attribute__((ext_vector_type(2))) __bf16 bf16x2_t;
DEV unsigned pack2(float a, float b) {
  f32x2_t v = {a, b};
  return __builtin_bit_cast(unsigned, __builtin_convertvector(v, bf16x2_t));
}
DEV u16 f2bf(float f) { return (u16)(pack2(f, 0.f) & 0xffffu); }
DEV float siluf(float x) { return x * __builtin_amdgcn_rcpf(1.f + __expf(-x)); }
DEV float sigmf(float x) { return __builtin_amdgcn_rcpf(1.f + __expf(-x)); }
DEV float wave_sum(float v) {
  v += __builtin_bit_cast(float, __builtin_amdgcn_mov_dpp(__builtin_bit_cast(int, v), 0xB1, 0xF, 0xF, true));
  v += __builtin_bit_cast(float, __builtin_amdgcn_mov_dpp(__builtin_bit_cast(int, v), 0x4E, 0xF, 0xF, true));
  v += __builtin_bit_cast(float, __builtin_amdgcn_mov_dpp(__builtin_bit_cast(int, v), 0x141, 0xF, 0xF, true));
  v += __builtin_bit_cast(float, __builtin_amdgcn_mov_dpp(__builtin_bit_cast(int, v), 0x140, 0xF, 0xF, true));
  v += __shfl_xor(v, 16);
  v += __shfl_xor(v, 32);
  return v;
}
DEV int ltid() { int z = 0; asm volatile("" : "+v"(z)); return (int)threadIdx.x + z; }
DEV float quad_sum(float v) {
  v += __builtin_bit_cast(float, __builtin_amdgcn_mov_dpp(__builtin_bit_cast(int, v), 0xB1, 0xF, 0xF, true));
  v += __builtin_bit_cast(float, __builtin_amdgcn_mov_dpp(__builtin_bit_cast(int, v), 0x4E, 0xF, 0xF, true));
  return v;
}
DEV int row_mi(int row) { return row < MP ? 0 : 1 + ((row - MP) >> 12); }

DEV void mod_phase(const Params& p) {
  const int TIDX = ltid();
  LDS_DECL;
  float* sc = (float*)lds_raw;
  float* red = sc + 3 * 1024;
  const int tid = TIDX;
  const float* cl = p.in[8];
  const float* cc = p.in[9];
  for (int i = tid; i < 3072; i += NTH) {
    int m = i >> 10, k = i & 1023;
    float v = (m == 0) ? cc[k] : cl[(m - 1) * 1024 + k];
    sc[i] = siluf(v);
  }
  __syncthreads();
  float* MOD = (float*)(p.ws + WS_MOD);
  const float* wm = p.in[10];
  const float* bm = p.in[11];
  const int col = tid % 72, kp = tid / 72;
  float* red72 = sc + 3 * 1024;
  for (int u = blockIdx.x; u < 256; u += gridDim.x) {
    int l = u >> 7, j0 = (u & 127) * 72;
    float a0 = 0.f, a1 = 0.f, a2 = 0.f;
    if (kp < 7) {
      const int k0 = kp * 147, k1 = min(1024, k0 + 147);
      const float* w = wm + ((size_t)l * 1024 + k0) * 9216 + j0 + col;
#pragma unroll 7
      for (int k = k0; k < k1; ++k) {
        float wv = w[(size_t)(k - k0) * 9216];
        a0 += sc[k] * wv; a1 += sc[1024 + k] * wv; a2 += sc[2048 + k] * wv;
      }
      red72[(kp * 3 + 0) * 72 + col] = a0; red72[(kp * 3 + 1) * 72 + col] = a1; red72[(kp * 3 + 2) * 72 + col] = a2;
    }
    __syncthreads();
    if (tid < 216) {
      int m = tid / 72, c = tid % 72;
      float s = bm[l * 9216 + j0 + c];
#pragma unroll
      for (int q = 0; q < 7; ++q) s += red72[(q * 3 + m) * 72 + c];
      MOD[(l * 3 + m) * 9216 + j0 + c] = s;
    }
    __syncthreads();
  }
}

DEV void conv_decode(const Params& p, int l, int u, const float*& src, int& K, int& Nsrc, u16*& dst, int& kt, int& nt, bool& perm) {
  int v = u;
  if (v < 2816) {
    int f = v / 1408; v %= 1408;
    src = p.in[14] + ((size_t)(l * 2 + f)) * DM * NGU; K = DM; Nsrc = NGU; dst = (u16*)(p.ws + WS_WGU + f * SZ_WGU1); kt = v % 16; nt = v / 16; perm = true;
  } else if (v < 4224) {
    v -= 2816; int f = v / 704; v %= 704;
    src = p.in[15] + ((size_t)(l * 2 + f)) * DFF * DM; K = DFF; Nsrc = DM; dst = (u16*)(p.ws + WS_WDN + f * SZ_WDN1); kt = v % 44; nt = v / 44; perm = false;
  } else if (v < 4992) {
    v -= 4224;
    src = p.in[16] + (size_t)l * DM * NIN; K = DM; Nsrc = NIN; dst = (u16*)(p.ws + WS_WIN); kt = v % 16; nt = v / 16; perm = false;
  } else if (v < 5248) {
    v -= 4992;
    src = p.in[17] + (size_t)l * DM * DM; K = DM; Nsrc = DM; dst = (u16*)(p.ws + WS_WOUT); kt = v % 16; nt = v / 16; perm = false;
  } else if (v < 5266) {
    v -= 5248;
    src = p.in[20] + (size_t)l * 192 * 384; K = 192; Nsrc = 384; dst = (u16*)(p.ws + WS_WUQ); kt = v % 3; nt = v / 3; perm = false;
  } else {
    v -= 5266; if (v > 15) v = 15;
    src = p.in[21] + (size_t)l * 128 * 512; K = 128; Nsrc = 512; dst = (u16*)(p.ws + WS_WUKV); kt = v % 2; nt = v / 2; perm = false;
  }
}
DEV void conv_phase(const Params& p, int l) {
  const int TIDX = ltid();
  LDS_DECL;
  float* tb = (float*)lds_raw;
  const int tid = TIDX;
  for (int g = (int)gridDim.x - 1 - (int)blockIdx.x; g < 1321; g += gridDim.x) {
    __syncthreads();
#pragma unroll 1
    for (int q = 0; q < 4; ++q) {
      const float* src; int K, Nsrc, kt, nt; u16* dst; bool perm;
      conv_decode(p, l, g * 4 + q, src, K, Nsrc, dst, kt, nt, perm);
      float* t = tb + q * (64 * 65);
#pragma unroll
      for (int i = 0; i < 2; ++i) {
        int e = tid + i * NTH; int kk = e >> 4, nn = (e & 15) * 4;
        int np = nt * 64 + nn;
        int sc_ = np;
        if (perm) { int blk = np >> 5, w = np & 31; sc_ = (w < 16) ? blk * 16 + w : DFF + blk * 16 + (w - 16); }
        float4 v = make_float4(0.f, 0.f, 0.f, 0.f);
        if (sc_ < Nsrc) v = *(const float4*)(src + (size_t)(kt * 64 + kk) * Nsrc + sc_);
        t[kk * 65 + nn] = v.x; t[kk * 65 + nn + 1] = v.y; t[kk * 65 + nn + 2] = v.z; t[kk * 65 + nn + 3] = v.w;
      }
    }
    __syncthreads();
#pragma unroll 1
    for (int q = 0; q < 4; ++q) {
      const float* src; int K, Nsrc, kt, nt; u16* dst; bool perm;
      conv_decode(p, l, g * 4 + q, src, K, Nsrc, dst, kt, nt, perm);
      const float* t = tb + q * (64 * 65);
#pragma unroll
      for (int i = 0; i < 4; ++i) {
        int e = tid + i * NTH; int nn = e >> 5, kp = e & 31;
        unsigned v = pack2(t[(2 * kp) * 65 + nn], t[(2 * kp + 1) * 65 + nn]);
        *(unsigned*)(dst + (size_t)(nt * 64 + nn) * K + kt * 64 + 2 * kp) = v;
      }
    }
  }
  __syncthreads();
}

DEV void init_phase(const Params& p) {
  const int TIDX = ltid();
  const float* MOD = (const float*)(p.ws + WS_MOD);
  float4* X4 = (float4*)(p.ws + WS_X);
  u16* H = (u16*)(p.ws + WS_H);
  const size_t n4 = (size_t)MTOT * 256;
  for (size_t e = (size_t)blockIdx.x * NTH + TIDX; e < n4; e += (size_t)gridDim.x * NTH) {
    int row = (int)(e >> 8), c = (int)(e & 255) * 4;
    float4 v = (row < MP) ? ((const float4*)p.in[0])[e] : ((const float4*)p.in[1])[e - (size_t)MP * 256];
    X4[e] = v;
    const float* mo = MOD + row_mi(row) * 9216;
    float4 sh = *(const float4*)(mo + c), scl = *(const float4*)(mo + 1024 + c);
    uint2 o;
    o.x = pack2(v.x * (1.f + scl.x) + sh.x, v.y * (1.f + scl.y) + sh.y);
    o.y = pack2(v.z * (1.f + scl.z) + sh.z, v.w * (1.f + scl.w) + sh.w);
    *(uint2*)(H + (size_t)row * 1024 + c) = o;
  }
}

DEV void ln_phase(const Params& p, int l, int sub) {
  const int TIDX = ltid();
  const float* MOD = (const float*)(p.ws + WS_MOD);
  const float* g = p.in[12] + (l * 3 + sub) * 1024;
  const float* bb = p.in[13] + (l * 3 + sub) * 1024;
  const bool fin = (l == 1 && sub == 2);
  const int nl = sub < 2 ? l : l + 1, ns = sub < 2 ? sub + 1 : 0;
  float* X = (float*)(p.ws + WS_X);
  u16* H = (u16*)(p.ws + WS_H);
  const int lane = TIDX & 63, wave = TIDX >> 6;
  for (int grp = blockIdx.x * 8 + wave; grp < MTOT / 8; grp += gridDim.x * 8) {
    const int row0 = grp * 8;
    const float* mo = MOD + (nl * 3 + row_mi(row0)) * 9216 + ns * 3072;
    float4 gg[4], b4[4], sh[4], scl[4];
#pragma unroll
    for (int i = 0; i < 4; ++i) {
      const int c = i * 256 + lane * 4;
      gg[i] = *(const float4*)(g + c); b4[i] = *(const float4*)(bb + c);
      if (!fin) { sh[i] = *(const float4*)(mo + c); scl[i] = *(const float4*)(mo + 1024 + c); }
      else { sh[i] = make_float4(0.f, 0.f, 0.f, 0.f); scl[i] = sh[i]; }
    }
#pragma unroll 2
    for (int r = 0; r < 8; ++r) {
      const int row = row0 + r;
      float4 v[4];
      float s = 0.f;
#pragma unroll
      for (int i = 0; i < 4; ++i) { v[i] = *(const float4*)(X + (size_t)row * 1024 + i * 256 + lane * 4); s += v[i].x + v[i].y + v[i].z + v[i].w; }
      float mean = wave_sum(s) * (1.f / 1024.f);
      float q = 0.f;
#pragma unroll
      for (int i = 0; i < 4; ++i) {
        v[i].x -= mean; v[i].y -= mean; v[i].z -= mean; v[i].w -= mean;
        q += v[i].x * v[i].x + v[i].y * v[i].y + v[i].z * v[i].z + v[i].w * v[i].w;
      }
      float rs = rsqrtf(wave_sum(q) * (1.f / 1024.f) + EPS_F);
#pragma unroll
      for (int i = 0; i < 4; ++i) {
        int c = i * 256 + lane * 4;
        float4 y;
        y.x = v[i].x * rs * gg[i].x + b4[i].x; y.y = v[i].y * rs * gg[i].y + b4[i].y;
        y.z = v[i].z * rs * gg[i].z + b4[i].z; y.w = v[i].w * rs * gg[i].w + b4[i].w;
        if (fin) {
          *(float4*)(p.out + (size_t)row * 1024 + c) = y;
        } else {
          *(float4*)(X + (size_t)row * 1024 + c) = y;
          uint2 o;
          o.x = pack2(y.x * (1.f + scl[i].x) + sh[i].x, y.y * (1.f + scl[i].y) + sh[i].y);
          o.y = pack2(y.z * (1.f + scl[i].z) + sh[i].z, y.w * (1.f + scl[i].w) + sh[i].w);
          *(uint2*)(H + (size_t)row * 1024 + c) = o;
        }
      }
    }
  }
}

constexpr int BM = 256, BK = 64, HALF = 128, NXCD = 8, WGM = 8, HT = HALF * BK;
DEV int lds_byte(int r, int c) {
  int st = (r >> 4) * 2 + (c >> 5), rr = r & 15, cc = c & 31, ob = rr * 64 + cc * 2;
  return st * 1024 + (ob ^ (((ob >> 9) & 1) << 5));
}
DEV void stage_rc(int b, int& R, int& C) {
  int st = b / 1024, sb = b % 1024, swz = sb ^ (((sb >> 9) & 1) << 5);
  R = (st >> 1) * 16 + swz / 64; C = (st & 1) * 32 + (swz % 64) / 2;
}
enum { EPI_SWIGLU = 0, EPI_RESID = 1, EPI_PROJ = 2 };

template <int EPI>
DEV void gemm_phase(size_t offA, size_t offB, int M, int N, int K, size_t offGate, float gscale) {
  const int TIDX = ltid();
  const u16* A; const u16* Bt;
  { Params p0 = getp(); A = (const u16*)(p0.ws + offA); Bt = (const u16*)(p0.ws + offB); }
  extern __shared__ __attribute__((aligned(16))) u16 shm[];
#define SA(b, h) (shm + ((b) * 2 + (h)) * HT)
#define SB(b, h) (shm + (4 + (b) * 2 + (h)) * HT)
#define STAGE(P, BASE, br, kt) do { const int _so = ((br) * K + (kt) * BK) * 2; \
    __builtin_amdgcn_raw_ptr_buffer_load_lds(rs##BASE, (__attribute__((address_space(3))) void*)((char*)(P) + TIDX * 16), 16, toff0, _so, 0, 0); \
    __builtin_amdgcn_raw_ptr_buffer_load_lds(rs##BASE, (__attribute__((address_space(3))) void*)((char*)(P) + TIDX * 16 + 8192), 16, toff0, _so + K * 128, 0, 0); } while (0)
#define LDA(dst, b, h) for (int m = 0; m < 4; ++m) for (int k = 0; k < 2; ++k) \
    dst[m][k] = *reinterpret_cast<const bf16x8*>((char*)SA(b, h) + lds_byte(wr * 64 + m * 16 + fr, k * 32 + fq * 8))
#define LDB(dst, b, h) for (int n = 0; n < 2; ++n) for (int k = 0; k < 2; ++k) \
    dst[n][k] = *reinterpret_cast<const bf16x8*>((char*)SB(b, h) + lds_byte(wc * 32 + n * 16 + fr, k * 32 + fq * 8))
#define MMA(ai, bj, At, Bt_) do { __builtin_amdgcn_s_setprio(1); \
    for (int m = 0; m < 4; ++m) for (int n = 0; n < 2; ++n) for (int k = 0; k < 2; ++k) \
      acc[ai][bj][m][n] = __builtin_amdgcn_mfma_f32_16x16x32_bf16(At[m][k], Bt_[n][k], acc[ai][bj][m][n], 0, 0, 0); \
    __builtin_amdgcn_s_setprio(0); } while (0)
#define WAIT_V(n) asm volatile("s_waitcnt vmcnt(" #n ")" ::: "memory")
#define WAIT_L(n) asm volatile("s_waitcnt lgkmcnt(" #n ")" ::: "memory")
#define BAR __builtin_amdgcn_s_barrier()
#define SCHED __builtin_amdgcn_sched_barrier(0)

  const int nM = M / BM, nN = N / BM, nwg = nM * nN;
  const int wid = __builtin_amdgcn_readfirstlane(TIDX >> 6), lane = TIDX & 63, wr = wid >> 2, wc = wid & 3, fr = lane & 15, fq = lane >> 4;
  const int nt = K / BK;
  int toff0;
  { int _r, _c; stage_rc(TIDX * 16, _r, _c); toff0 = (_r * K + _c) * 2; }
  const __amdgpu_buffer_rsrc_t rsA = __builtin_amdgcn_make_buffer_rsrc((void*)A, 0, 0x7ffffff0, 0x00020000);
  const __amdgpu_buffer_rsrc_t rsBt = __builtin_amdgcn_make_buffer_rsrc((void*)Bt, 0, 0x7ffffff0, 0x00020000);
  for (int vt = blockIdx.x; vt < nwg; vt += gridDim.x) {
    int wgid = vt;
    { int q = nwg / NXCD, r = nwg % NXCD, xcd = wgid % NXCD, off = wgid / NXCD;
      wgid = (xcd < r ? xcd * (q + 1) : r * (q + 1) + (xcd - r) * q) + off; }
    int nig = WGM * nN, gid = wgid / nig, fm = gid * WGM, gsz = min(nM - fm, WGM);
    int pm = fm + ((wgid % nig) % gsz), pn = (wgid % nig) / gsz, brow = pm * BM, bcol = pn * BM;
    f32x4 acc[2][2][4][2] = {};
    bf16x8 At[4][2], B0[2][2], B1[2][2];
    __syncthreads();
    STAGE(SB(0, 0), Bt, bcol, 0); STAGE(SA(0, 0), A, brow, 0);
    STAGE(SB(0, 1), Bt, bcol + HALF, 0); STAGE(SA(0, 1), A, brow + HALF, 0);
    if (wr == 1) BAR;
    WAIT_V(4); BAR;
    STAGE(SB(1, 0), Bt, bcol, 1); STAGE(SA(1, 0), A, brow, 1); STAGE(SB(1, 1), Bt, bcol + HALF, 1);
    WAIT_V(6); BAR;
    for (int t = 0; t < nt - 2; t += 2) {
      LDB(B0, 0, 0); SCHED; LDA(At, 0, 0); STAGE(SA(1, 1), A, brow + HALF, t + 1);
      WAIT_L(8); BAR; WAIT_L(0); MMA(0, 0, At, B0); BAR; SCHED;
      LDB(B1, 0, 1); STAGE(SB(0, 0), Bt, bcol, t + 2);
      BAR; WAIT_L(0); MMA(0, 1, At, B1); BAR;
      LDA(At, 0, 1); STAGE(SA(0, 0), A, brow, t + 2);
      BAR; WAIT_L(0); MMA(1, 0, At, B0); BAR; SCHED;
      STAGE(SB(0, 1), Bt, bcol + HALF, t + 2);
      WAIT_V(6); BAR; MMA(1, 1, At, B1); BAR;
      LDB(B0, 1, 0); SCHED; LDA(At, 1, 0); STAGE(SA(0, 1), A, brow + HALF, t + 2);
      WAIT_L(8); BAR; WAIT_L(0); MMA(0, 0, At, B0); BAR; SCHED;
      LDB(B1, 1, 1); STAGE(SB(1, 0), Bt, bcol, t + 3);
      BAR; WAIT_L(0); MMA(0, 1, At, B1); BAR;
      LDA(At, 1, 1); STAGE(SA(1, 0), A, brow, t + 3);
      BAR; WAIT_L(0); MMA(1, 0, At, B0); BAR; SCHED;
      STAGE(SB(1, 1), Bt, bcol + HALF, t + 3);
      WAIT_V(6); BAR; MMA(1, 1, At, B1); BAR;
    }
    { LDB(B0, 0, 0); LDA(At, 0, 0); STAGE(SA(1, 1), A, brow + HALF, nt - 1);
      BAR; WAIT_L(0); MMA(0, 0, At, B0); BAR;
      LDB(B1, 0, 1); BAR; WAIT_L(0); MMA(0, 1, At, B1); BAR;
      LDA(At, 0, 1); WAIT_V(4); BAR; WAIT_L(0); MMA(1, 0, At, B0); MMA(1, 1, At, B1); BAR; }
    { LDB(B0, 1, 0); LDA(At, 1, 0); WAIT_V(2); BAR; WAIT_L(0); MMA(0, 0, At, B0); BAR;
      LDB(B1, 1, 1); WAIT_V(0); BAR; WAIT_L(0); MMA(0, 1, At, B1); BAR;
      LDA(At, 1, 1); BAR; WAIT_L(0); MMA(1, 0, At, B0); MMA(1, 1, At, B1); BAR; }
    if (wr == 0) BAR;
    const int mi = row_mi(brow);
    Params p1 = getp();
    float* Xres = (float*)(p1.ws + WS_X);
    const float* gate = (const float*)(p1.ws + WS_MOD) + offGate;
    u16* outb = (u16*)(p1.ws + WS_R1);
    float gsc[2][2];
    if (EPI == EPI_RESID) {
#pragma unroll
      for (int bj = 0; bj < 2; ++bj)
#pragma unroll
        for (int n = 0; n < 2; ++n) gsc[bj][n] = gscale * gate[mi * 9216 + bcol + bj * HALF + wc * 32 + n * 16 + fr];
    }
#pragma unroll
    for (int ai = 0; ai < 2; ++ai)
#pragma unroll
      for (int bj = 0; bj < 2; ++bj)
#pragma unroll
        for (int m = 0; m < 4; ++m)
#pragma unroll
          for (int j = 0; j < 4; ++j) {
            const int row = brow + ai * HALF + wr * 64 + m * 16 + fq * 4 + j;
            const int cb = bcol + bj * HALF + wc * 32;
            if (EPI == EPI_SWIGLU) {
              float gv = acc[ai][bj][m][0][j], uv = acc[ai][bj][m][1][j];
              outb[(size_t)row * DFF + (cb >> 1) + fr] = f2bf(siluf(gv) * uv);
            } else if (EPI == EPI_RESID) {
#pragma unroll
              for (int n = 0; n < 2; ++n) {
                int col = cb + n * 16 + fr;
                size_t ix = (size_t)row * DM + col;
                Xres[ix] = ALPHA_F * Xres[ix] + gsc[bj][n] * acc[ai][bj][m][n][j];
              }
            } else {
#pragma unroll
              for (int n = 0; n < 2; ++n) outb[(size_t)row * NINP + cb + n * 16 + fr] = f2bf(acc[ai][bj][m][n][j]);
            }
          }
  }
  __syncthreads();
}

DEV void rope_cs(int pos, int fi, float nfreq, float& c, float& s) {
  float inv = exp2f(-(float)fi / nfreq * 13.287712379549449f);
  __sincosf((float)pos * inv, &s, &c);
}

DEV void prep_phase(const Params& p, int l) {
  const int TIDX = ltid();
  LDS_DECL;
  float* raw = (float*)lds_raw;
  const int tid = TIDX, lane = tid & 63, wave = tid >> 6;
  const u16* PROJ = (const u16*)(p.ws + WS_R1);
  u16* QA = (u16*)(p.ws + WS_QA); u16* KA = (u16*)(p.ws + WS_KA); u16* VA = (u16*)(p.ws + WS_VA);
  u16* QD = (u16*)(p.ws + WS_QD); u16* KD = (u16*)(p.ws + WS_KD);
  const float* wuq = p.in[20] + (size_t)l * 192 * 384;
  const float* wukv = p.in[21] + (size_t)l * 128 * 512;
  const float* gq = p.in[18] + l * 192;
  const float* gkv = p.in[19] + l * 128;
  const float qsA = 0.10206207261596577f * LOG2E;
  const float qsD = 0.125f * LOG2E;
  for (int u = blockIdx.x; u < 544; u += gridDim.x) {
    const bool cache = u >= 512;
    int row0 = 0, cb = 0, cpos0 = 0;
    if (!cache) row0 = u * 32; else { cb = (u - 512) >> 4; cpos0 = ((u - 512) & 15) * 32; }
    const bool lat = cache || row0 >= MP;
    __syncthreads();
    if (!cache) {
      for (int e = tid; e < 32 * 44; e += NTH) {
        int r = e / 44, c = (e % 44) * 8;
        uint4 v = *(const uint4*)(PROJ + (size_t)(row0 + r) * NINP + c);
        float* d = raw + r * 352 + c;
        d[0] = bf2f(v.x & 0xffff); d[1] = bf2f(v.x >> 16); d[2] = bf2f(v.y & 0xffff); d[3] = bf2f(v.y >> 16);
        d[4] = bf2f(v.z & 0xffff); d[5] = bf2f(v.z >> 16); d[6] = bf2f(v.w & 0xffff); d[7] = bf2f(v.w >> 16);
      }
    } else {
      const float* ck = p.in[2] + ((size_t)(cb * 2 + l) * 512 + cpos0) * 128;
      const float* cr = p.in[3] + ((size_t)(cb * 2 + l) * 512 + cpos0) * 32;
      for (int e = tid; e < 32 * 128; e += NTH) raw[(e >> 7) * 352 + 192 + (e & 127)] = ck[e];
      for (int e = tid; e < 32 * 32; e += NTH) raw[(e >> 5) * 352 + 320 + (e & 31)] = cr[e];
    }
    __syncthreads();
    if (!cache) {
      for (int tsk = wave; tsk < 64; tsk += 8) {
        int r = tsk >> 1, which = tsk & 1;
        float* x = raw + r * 352 + (which ? 192 : 0);
        int n = which ? 128 : 192;
        float s = 0.f;
        for (int k = lane; k < n; k += 64) s += x[k] * x[k];
        float rs = rsqrtf(wave_sum(s) / (float)n + EPS_F);
        const float* gg = which ? gkv : gq;
        for (int k = lane; k < n; k += 64) x[k] = x[k] * rs * gg[k];
      }
    }
    __syncthreads();
    if (!cache && !lat) {
      int b = row0 >> 8, t0 = row0 & 255;
      for (int e = tid; e < 32 * 128; e += NTH) {
        int r = e >> 7, c = e & 127;
        size_t ob = ((size_t)(b * 2 + l) * 256 + t0 + r);
        p.out[O_CKV + ob * 128 + c] = raw[r * 352 + 192 + c];
        p.out[O_DK + ob * 128 + c] = bf2f(PROJ[(size_t)(row0 + r) * NINP + C_DK + c]);
        p.out[O_DV + ob * 128 + c] = bf2f(PROJ[(size_t)(row0 + r) * NINP + C_DV + c]);
      }
      for (int e = tid; e < 32 * 32; e += NTH) {
        int r = e >> 5, c = e & 31;
        p.out[O_KR + ((size_t)(b * 2 + l) * 256 + t0 + r) * 32 + c] = raw[r * 352 + 320 + c];
      }
    }
    {
      constexpr int XP = 328;
      u16* xa = (u16*)(raw + 32 * 352);
      for (int e = TIDX; e < 32 * 160; e += NTH) {
        int r = e / 160, k2 = (e % 160) * 2;
        *(unsigned*)(xa + r * XP + k2) = pack2(raw[r * 352 + k2], raw[r * 352 + k2 + 1]);
      }
      __syncthreads();
      const int fr = lane & 15, fq = lane >> 4;
      const u16* WUQ = (const u16*)(p.ws + WS_WUQ);
      const u16* WUKV = (const u16*)(p.ws + WS_WUKV);
#pragma unroll 1
      for (int ct = wave; ct < 56; ct += 8) {
        const bool isq = ct < 24;
        if (isq && cache) continue;
        const int Kd = isq ? 192 : 128, nks = Kd >> 5, koff = isq ? 0 : 192;
        const u16* wrow = isq ? (WUQ + (size_t)(ct * 16 + fr) * 192) : (WUKV + (size_t)((ct - 24) * 16 + fr) * 128);
        bf16x8 bfr[6];
#pragma unroll
        for (int ks = 0; ks < 6; ++ks) bfr[ks] = (ks < nks) ? *(const bf16x8*)(wrow + ks * 32 + fq * 8) : bfr[0];
        f32x4 acc2[2];
        acc2[0] = (f32x4){0.f, 0.f, 0.f, 0.f}; acc2[1] = acc2[0];
#pragma unroll
        for (int ks = 0; ks < 6; ++ks) {
          if (ks < nks) {
#pragma unroll
            for (int rt = 0; rt < 2; ++rt) {
              bf16x8 av = *(const bf16x8*)(xa + (rt * 16 + fr) * XP + koff + ks * 32 + fq * 8);
              acc2[rt] = __builtin_amdgcn_mfma_f32_16x16x32_bf16(av, bfr[ks], acc2[rt], 0, 0, 0);
            }
          }
        }
        const int c = ct * 16 + fr;
        if (isq) {
          const int d = c % 96;
          const bool rp = lat && d >= 64;
          const int dd = d - 64;
          const int ax = (dd >> 4) & 1, i16 = dd & 15, fi = i16 & 7;
#pragma unroll
          for (int rt = 0; rt < 2; ++rt)
#pragma unroll
            for (int r = 0; r < 4; ++r) {
              const int rl = rt * 16 + fq * 4 + r;
              const float self = acc2[rt][r];
              float other = __shfl_xor(self, 8);
              float val = self;
              if (rp) {
                int t = (row0 + rl - MP) & 4095;
                int pos = ax ? (t & 63) : (t >> 6);
                float cs, sn; rope_cs(pos, fi, 8.f, cs, sn);
                val = (i16 < 8) ? (self * cs - other * sn) : (other * sn + self * cs);
              }
              QA[(size_t)(row0 + rl) * 384 + c] = f2bf(val * qsA);
            }
        } else {
          const int cc = c - 384, h = cc >> 7, d = cc & 127;
#pragma unroll
          for (int rt = 0; rt < 2; ++rt)
#pragma unroll
            for (int r = 0; r < 4; ++r) {
              const int rl = rt * 16 + fq * 4 + r;
              const float self = acc2[rt][r];
              size_t krow;
              if (cache) krow = 8192 + (size_t)cb * 4608 + 4096 + cpos0 + rl;
              else if (!lat) krow = row0 + rl;
              else { int rr = row0 + rl - MP; krow = 8192 + (size_t)(rr >> 12) * 4608 + (rr & 4095); }
              if (d < 64) KA[krow * 384 + h * 96 + d] = f2bf(self);
              else VA[krow * 256 + h * 64 + (d - 64)] = f2bf(self);
            }
        }
      }
    }
    for (int e = tid; e < 32 * 32; e += NTH) {
      int r = e >> 5, j = e & 31;
      float val = raw[r * 352 + 320 + j];
      size_t krow;
      if (cache) krow = 8192 + (size_t)cb * 4608 + 4096 + cpos0 + r;
      else if (!lat) krow = row0 + r;
      else {
        int rr = row0 + r - MP; krow = 8192 + (size_t)(rr >> 12) * 4608 + (rr & 4095);
        int t = rr & 4095;
        int ax = j >> 4, i16 = j & 15, fi = i16 & 7;
        int pos = ax ? (t & 63) : (t >> 6);
        float cs, sn; rope_cs(pos, fi, 8.f, cs, sn);
        float other = raw[r * 352 + 320 + (j ^ 8)];
        val = (i16 < 8) ? (val * cs - other * sn) : (other * sn + val * cs);
      }
      u16 bv = f2bf(val);
#pragma unroll
      for (int h = 0; h < 4; ++h) KA[krow * 384 + h * 96 + 64 + j] = bv;
    }
    if (!cache) {
      for (int e = tid; e < 32 * 384; e += NTH) {
        int r = e / 384, c = e % 384;
        int row = row0 + r;
        const u16* src = PROJ + (size_t)row * NINP + (c < 256 ? C_DQ + c : C_DK + (c - 256));
        float val = bf2f(src[0]);
        if (lat) {
          int d = c & 63;
          int ax = d >> 5, i32 = d & 31, fi = i32 & 15;
          int t = (row - MP) & 4095;
          int pos = ax ? (t & 63) : (t >> 6);
          float cs, sn; rope_cs(pos, fi, 16.f, cs, sn);
          float other = bf2f((i32 < 16) ? src[16] : src[-16]);
          val = (i32 < 16) ? (val * cs - other * sn) : (other * sn + val * cs);
        }
        if (c < 256) QD[(size_t)row * 256 + c] = f2bf(val * qsD);
        else KD[(size_t)row * 128 + (c - 256)] = f2bf(val);
      }
    }
  }
  __syncthreads();
}

DEV bf16x8 mk8(unsigned a, unsigned b, unsigned c, unsigned d) {
  union { unsigned u[4]; bf16x8 v; } x; x.u[0] = a; x.u[1] = b; x.u[2] = c; x.u[3] = d; return x.v;
}
template <int DQK>
DEV void attn_seg(u16* Ks, u16* Vt, const void* kb, int kst, const void* vb, int vst, bool f32src,
                  int nkeys, int keypos0, bool masked, int qpos,
                  const bf16x8 (&qf)[2][DQK / 32], f32x4 (&o)[2][4], float (&m)[2], float (&l)[2]) {
  const int TIDX = ltid();
  constexpr int KP = DQK + 8, VP = 72;
  const int tid = TIDX, lane = tid & 63, fr = lane & 15, fq = lane >> 4;
  constexpr int NKC = 64 * DQK / 8;
  const int e1 = tid + NTH;
  const int kkey0 = tid / (DQK / 8), kc0 = (tid % (DQK / 8)) * 8;
  const int kkey1 = e1 / (DQK / 8), kc1 = (e1 % (DQK / 8)) * 8;
  const bool has1 = e1 < NKC;
  const int vkey = tid >> 3, vc = (tid & 7) * 8;
  uint4 rk0 = make_uint4(0, 0, 0, 0), rk1 = make_uint4(0, 0, 0, 0), rv = make_uint4(0, 0, 0, 0);
  if (!f32src) {
    rk0 = *(const uint4*)((const u16*)kb + (size_t)kkey0 * kst + kc0);
    if (has1) rk1 = *(const uint4*)((const u16*)kb + (size_t)kkey1 * kst + kc1);
    rv = *(const uint4*)((const u16*)vb + (size_t)vkey * vst + vc);
  }
  for (int k0 = 0; k0 < nkeys; k0 += 64) {
    __syncthreads();
    if (!f32src) {
      *(uint4*)(Ks + kkey0 * KP + kc0) = rk0;
      if (has1) *(uint4*)(Ks + kkey1 * KP + kc1) = rk1;
      Vt[(vc + 0) * VP + vkey] = (u16)(rv.x & 0xffff); Vt[(vc + 1) * VP + vkey] = (u16)(rv.x >> 16);
      Vt[(vc + 2) * VP + vkey] = (u16)(rv.y & 0xffff); Vt[(vc + 3) * VP + vkey] = (u16)(rv.y >> 16);
      Vt[(vc + 4) * VP + vkey] = (u16)(rv.z & 0xffff); Vt[(vc + 5) * VP + vkey] = (u16)(rv.z >> 16);
      Vt[(vc + 6) * VP + vkey] = (u16)(rv.w & 0xffff); Vt[(vc + 7) * VP + vkey] = (u16)(rv.w >> 16);
      if (k0 + 64 < nkeys) {
        const int kn = k0 + 64;
        rk0 = *(const uint4*)((const u16*)kb + (size_t)(kn + kkey0) * kst + kc0);
        if (has1) rk1 = *(const uint4*)((const u16*)kb + (size_t)(kn + kkey1) * kst + kc1);
        rv = *(const uint4*)((const u16*)vb + (size_t)(kn + vkey) * vst + vc);
      }
    } else {
      for (int e = tid; e < 64 * 16; e += NTH) {
        int key = e >> 4, c = (e & 15) * 4;
        float4 v = *(const float4*)((const float*)kb + (size_t)(k0 + key) * kst + c);
        uint2 w; w.x = pack2(v.x, v.y); w.y = pack2(v.z, v.w);
        *(uint2*)(Ks + key * KP + c) = w;
        float4 x = *(const float4*)((const float*)vb + (size_t)(k0 + key) * vst + c);
        Vt[(c + 0) * VP + key] = f2bf(x.x); Vt[(c + 1) * VP + key] = f2bf(x.y);
        Vt[(c + 2) * VP + key] = f2bf(x.z); Vt[(c + 3) * VP + key] = f2bf(x.w);
      }
    }
    __syncthreads();
    f32x4 s[2][4];
#pragma unroll
    for (int kt = 0; kt < 4; ++kt) {
      s[0][kt] = (f32x4){0.f, 0.f, 0.f, 0.f}; s[1][kt] = s[0][kt];
#pragma unroll
      for (int ks = 0; ks < DQK / 32; ++ks) {
        bf16x8 a = *(const bf16x8*)(Ks + (kt * 16 + fr) * KP + ks * 32 + fq * 8);
        s[0][kt] = __builtin_amdgcn_mfma_f32_16x16x32_bf16(a, qf[0][ks], s[0][kt], 0, 0, 0);
        s[1][kt] = __builtin_amdgcn_mfma_f32_16x16x32_bf16(a, qf[1][ks], s[1][kt], 0, 0, 0);
      }
    }
#pragma unroll
    for (int qt = 0; qt < 2; ++qt) {
      if (masked) {
#pragma unroll
        for (int kt = 0; kt < 4; ++kt)
#pragma unroll
          for (int r = 0; r < 4; ++r) {
            int df = keypos0 + k0 + kt * 16 + fq * 4 + r - (qpos + qt * 16);
            if (df > 128 || df < -128) s[qt][kt][r] = -INFINITY;
          }
      }
      float mx = m[qt];
#pragma unroll
      for (int kt = 0; kt < 4; ++kt)
#pragma unroll
        for (int r = 0; r < 4; ++r) mx = fmaxf(mx, s[qt][kt][r]);
      mx = fmaxf(mx, __shfl_xor(mx, 16));
      mx = fmaxf(mx, __shfl_xor(mx, 32));
      float alpha = __builtin_amdgcn_exp2f(m[qt] - mx);
      m[qt] = mx;
      float rs = 0.f;
#pragma unroll
      for (int kt = 0; kt < 4; ++kt)
#pragma unroll
        for (int r = 0; r < 4; ++r) { float pv = __builtin_amdgcn_exp2f(s[qt][kt][r] - mx); s[qt][kt][r] = pv; rs += pv; }
      rs += __shfl_xor(rs, 16);
      rs += __shfl_xor(rs, 32);
      l[qt] = l[qt] * alpha + rs;
#pragma unroll
      for (int dt = 0; dt < 4; ++dt) { o[qt][dt][0] *= alpha; o[qt][dt][1] *= alpha; o[qt][dt][2] *= alpha; o[qt][dt][3] *= alpha; }
    }
#pragma unroll
    for (int s2 = 0; s2 < 2; ++s2) {
      bf16x8 pb0 = mk8(pack2(s[0][2 * s2][0], s[0][2 * s2][1]), pack2(s[0][2 * s2][2], s[0][2 * s2][3]),
                       pack2(s[0][2 * s2 + 1][0], s[0][2 * s2 + 1][1]), pack2(s[0][2 * s2 + 1][2], s[0][2 * s2 + 1][3]));
      bf16x8 pb1 = mk8(pack2(s[1][2 * s2][0], s[1][2 * s2][1]), pack2(s[1][2 * s2][2], s[1][2 * s2][3]),
                       pack2(s[1][2 * s2 + 1][0], s[1][2 * s2 + 1][1]), pack2(s[1][2 * s2 + 1][2], s[1][2 * s2 + 1][3]));
#pragma unroll
      for (int dt = 0; dt < 4; ++dt) {
        const u16* vr = Vt + (dt * 16 + fr) * VP + s2 * 32 + fq * 4;
        uint2 v0 = *(const uint2*)vr, v1 = *(const uint2*)(vr + 16);
        bf16x8 a = mk8(v0.x, v0.y, v1.x, v1.y);
        o[0][dt] = __builtin_amdgcn_mfma_f32_16x16x32_bf16(a, pb0, o[0][dt], 0, 0, 0);
        o[1][dt] = __builtin_amdgcn_mfma_f32_16x16x32_bf16(a, pb1, o[1][dt], 0, 0, 0);
      }
    }
  }
}

DEV void attn_store(const f32x4 (&o)[4], float l, u16* outp  ) {
  const int TIDX = ltid();
  const int lane = TIDX & 63, fq = lane >> 4;
  float inv = 1.f / l;
#pragma unroll
  for (int dt = 0; dt < 4; ++dt) {
    uint2 w; w.x = pack2(o[dt][0] * inv, o[dt][1] * inv); w.y = pack2(o[dt][2] * inv, o[dt][3] * inv);
    *(uint2*)(outp + dt * 16 + fq * 4) = w;
  }
}

DEV void attnA_item(const Params& p, int grp, int b, int h, int qb) {
  const int TIDX = ltid();
  LDS_DECL;
  u16* Ks = (u16*)lds_raw; u16* Vt = Ks + 64 * 104;
  const int tid = TIDX, lane = tid & 63, wave = tid >> 6, fr = lane & 15, fq = lane >> 4;
  const u16* QA = (const u16*)(p.ws + WS_QA); const u16* KA = (const u16*)(p.ws + WS_KA); const u16* VA = (const u16*)(p.ws + WS_VA);
  u16* MIX = (u16*)(p.ws + WS_H);
  const int row = (grp ? MP + b * 4096 : b * 256) + qb * 256 + wave * 32 + fr;
  size_t krow0 = grp ? (size_t)8192 + (size_t)b * 4608 : (size_t)b * 256;
  int nk = grp ? 4608 : 256;
  bf16x8 qf[2][3];
#pragma unroll
  for (int qt = 0; qt < 2; ++qt)
#pragma unroll
    for (int ks = 0; ks < 3; ++ks) qf[qt][ks] = *(const bf16x8*)(QA + (size_t)(row + qt * 16) * 384 + h * 96 + ks * 32 + fq * 8);
  f32x4 o[2][4];
#pragma unroll
  for (int qt = 0; qt < 2; ++qt)
#pragma unroll
    for (int i = 0; i < 4; ++i) o[qt][i] = (f32x4){0.f, 0.f, 0.f, 0.f};
  float m[2] = {-1e30f, -1e30f}, l[2] = {0.f, 0.f};
  attn_seg<96>(Ks, Vt, KA + krow0 * 384 + h * 96, 384, VA + krow0 * 256 + h * 64, 256, false, nk, 0, false, 0, qf, o, m, l);
  attn_store(o[0], l[0], MIX + (size_t)row * 1024 + h * 64);
  attn_store(o[1], l[1], MIX + (size_t)(row + 16) * 1024 + h * 64);
  __syncthreads();
}

DEV void attnD_item(const Params& p, int l_, int grp, int b, int h, int qb) {
  const int TIDX = ltid();
  LDS_DECL;
  u16* Ks = (u16*)lds_raw; u16* Vt = Ks + 64 * 72;
  const int tid = TIDX, lane = tid & 63, wave = tid >> 6, fr = lane & 15, fq = lane >> 4;
  const u16* QD = (const u16*)(p.ws + WS_QD); const u16* KD = (const u16*)(p.ws + WS_KD);
  const u16* PROJ = (const u16*)(p.ws + WS_R1);
  u16* MIX = (u16*)(p.ws + WS_H);
  const int kvh = h >> 1;
  int rowb = grp ? MP + b * 4096 : b * 256;
  int qloc = qb * 256 + wave * 32 + fr;
  int row = rowb + qloc;
  bf16x8 qf[2][2];
#pragma unroll
  for (int qt = 0; qt < 2; ++qt)
#pragma unroll
    for (int ks = 0; ks < 2; ++ks) qf[qt][ks] = *(const bf16x8*)(QD + (size_t)(row + qt * 16) * 256 + h * 64 + ks * 32 + fq * 8);
  f32x4 o[2][4];
#pragma unroll
  for (int qt = 0; qt < 2; ++qt)
#pragma unroll
    for (int i = 0; i < 4; ++i) o[qt][i] = (f32x4){0.f, 0.f, 0.f, 0.f};
  const float sk = p.in[30][l_ * 4 + h] * LOG2E;
  float m[2] = {sk, sk}, l[2] = {1.f, 1.f};
  if (!grp) {
    attn_seg<64>(Ks, Vt, KD + (size_t)rowb * 128 + kvh * 64, 128, PROJ + (size_t)rowb * NINP + C_DV + kvh * 64, NINP, false,
                 256, 0, false, 0, qf, o, m, l);
  } else {
    int q0 = qb * 256;
    int ks = max(0, q0 - 128), ke = min(4096, q0 + 384);
    attn_seg<64>(Ks, Vt, KD + (size_t)(rowb + ks) * 128 + kvh * 64, 128, PROJ + (size_t)(rowb + ks) * NINP + C_DV + kvh * 64, NINP, false,
                 ke - ks, ks, true, qloc, qf, o, m, l);
    const float* ck = p.in[6] + ((size_t)(b * 2 + l_) * 512) * 128 + kvh * 64;
    const float* cv = p.in[7] + ((size_t)(b * 2 + l_) * 512) * 128 + kvh * 64;
    attn_seg<64>(Ks, Vt, ck, 128, cv, 128, true, 512, 0, false, 0, qf, o, m, l);
  }
  attn_store(o[0], l[0], MIX + (size_t)row * 1024 + 768 + h * 64);
  attn_store(o[1], l[1], MIX + (size_t)(row + 16) * 1024 + 768 + h * 64);
  __syncthreads();
}

DEV void ssd_item(const Params& p, int l, int grp, int b, int h, int mode, int seg) {
  const int TIDX = ltid();
  LDS_DECL;
  const int tid = TIDX, dir = tid >> 8, lt = tid & 255, pp = lt >> 2, nq = lt & 3;
  constexpr int HALF_FLOATS = 3 * 2048 + 32 + (36 * 192) / 2 + 6 * 192 + 32;
  float* base = (float*)lds_raw + dir * HALF_FLOATS;
  float* xs = base; float* Bs = base + 2048; float* Cs = base + 4096; float* dts = base + 6144;
  u16* raw = (u16*)(base + 6144 + 32);
  float* wl = base + 6144 + 32 + (36 * 192) / 2;
  const u16* PROJ = (const u16*)(p.ws + WS_R1);
  float* Yd = (float*)(p.ws + (dir ? WS_YB : WS_YF));
  const int T = grp ? 4096 : 256;
  const int rowb = grp ? MP + b * 4096 : b * 256;
  const int g = h >> 1;
  const float a = -__expf(p.in[24][(l * 2 + dir) * 4 + h]);
  const float dtb = p.in[25][(l * 2 + dir) * 4 + h];
  const float Dk = p.in[26][(l * 2 + dir) * 4 + h];
  const float* cw = p.in[22] + (size_t)l * 5 * 512;
  const float* cbias = p.in[23] + l * 512;
  float S[16];
  float* SLOC = (float*)(p.ws + WS_SSLOC) + ((size_t)((b * 4 + h) * 2 + dir) * NSEG) * 4096 + pp * 64 + nq * 16;
  float* SDEC = (float*)(p.ws + WS_SDEC) + ((b * 4 + h) * 2 + dir) * NSEG;
  if (mode == 2) {
    const float* s0 = p.in[4] + ((((size_t)(b * 2 + l) * 2 + dir) * 4 + h) * 64 + pp) * 64 + nq * 16;
#pragma unroll
    for (int i = 0; i < 16; ++i) S[i] = s0[i];
    const int npre = dir ? NSEG - 1 - seg : seg;
    for (int q = 0; q < npre; ++q) {
      const int sg = dir ? NSEG - 1 - q : q;
      const float dd = SDEC[sg];
      const float* sl = SLOC + (size_t)sg * 4096;
#pragma unroll
      for (int i = 0; i < 16; ++i) S[i] = dd * S[i] + sl[i];
    }
  } else {
#pragma unroll
    for (int i = 0; i < 16; ++i) S[i] = 0.f;
  }
  const int tbeg = (mode == 0) ? 0 : seg * SEGLEN;
  const int tlen = (mode == 0) ? T : SEGLEN;
  float dsum = 0.f;
  __syncthreads();
  for (int e = lt; e < 6 * 192; e += 256) {
    int j = e / 192, ch3 = e % 192, which = ch3 >> 6, cc = ch3 & 63;
    int ch = (which == 0) ? h * 64 + cc : 256 + (which - 1) * 128 + g * 64 + cc;
    wl[e] = (j < 5) ? cw[j * 512 + ch] : cbias[ch];
  }
  const int nch = tlen / 32;
  float* dAs = wl + 6 * 192;
  uint4 pre0, pre1, pre2, pre3;
  float predt = 0.f;
#define SSD_FETCH(ci_) do { \
    const int c_ = dir ? nch - 1 - (ci_) : (ci_); \
    const int t0_ = tbeg + c_ * 32; \
    _Pragma("unroll") \
    for (int i = 0; i < 4; ++i) { \
      const int e = lt + i * 256; \
      uint4 v = make_uint4(0u, 0u, 0u, 0u); \
      if (e < 36 * 24) { \
        int rr = e / 24, q = e % 24, which = q >> 3, c8 = (q & 7) * 8; \
        int t = t0_ + rr - 2; \
        int ch = (which == 0) ? h * 64 + c8 : 256 + (which - 1) * 128 + g * 64 + c8; \
        if (t >= 0 && t < T) v = *(const uint4*)(PROJ + (size_t)(rowb + t) * NINP + C_BXBC + ch); \
      } \
      if (i == 0) pre0 = v; else if (i == 1) pre1 = v; else if (i == 2) pre2 = v; else pre3 = v; \
    } \
    if (lt < 32) predt = bf2f(PROJ[(size_t)(rowb + t0_ + lt) * NINP + C_BDT + dir * 4 + h]); \
  } while (0)
  SSD_FETCH(0);
  for (int ci = 0; ci < nch; ++ci) {
    const int c = dir ? nch - 1 - ci : ci;
    const int t0 = tbeg + c * 32;
    __syncthreads();
#pragma unroll
    for (int i = 0; i < 4; ++i) {
      const int e = lt + i * 256;
      const uint4 pv = (i == 0) ? pre0 : (i == 1) ? pre1 : (i == 2) ? pre2 : pre3;
      if (e < 36 * 24) { int rr = e / 24, q = e % 24; *(uint4*)(raw + rr * 192 + (q >> 3) * 64 + (q & 7) * 8) = pv; }
    }
    if (lt < 32) {
      float x = predt + dtb;
      float dtv = fmaxf(x, 0.f) + log1pf(__expf(-fabsf(x)));
      dts[lt] = dtv;
      dAs[lt] = __expf(dtv * a);
    }
    __syncthreads();
    if (ci + 1 < nch) SSD_FETCH(ci + 1);
    if (lt < 192) {
      const int ch3 = lt, which = ch3 >> 6, cc = ch3 & 63;
      const float w0 = wl[ch3], w1 = wl[192 + ch3], w2 = wl[384 + ch3], w3 = wl[576 + ch3], w4 = wl[768 + ch3], wb = wl[960 + ch3];
      float x0 = bf2f(raw[ch3]), x1 = bf2f(raw[192 + ch3]), x2 = bf2f(raw[384 + ch3]), x3 = bf2f(raw[576 + ch3]);
      float* dst = base + which * 2048 + cc;
#pragma unroll 8
      for (int tt = 0; tt < 32; ++tt) {
        const float x4 = bf2f(raw[(tt + 4) * 192 + ch3]);
        const float accv = wb + w0 * x0 + w1 * x1 + w2 * x2 + w3 * x3 + w4 * x4;
        dst[tt * 64] = siluf(accv);
        x0 = x1; x1 = x2; x2 = x3; x3 = x4;
      }
    }
    __syncthreads();
#pragma unroll 4
    for (int s = 0; s < 32; ++s) {
      const int tt = dir ? 31 - s : s;
      float dtv = dts[tt];
      float dA = dAs[tt];
      float xv = xs[tt * 64 + pp];
      float coef = dtv * xv;
      dsum += dtv;
      if (mode == 1) {
#pragma unroll
        for (int i = 0; i < 16; i += 4) {
          float4 bv = *(const float4*)(Bs + tt * 64 + nq * 16 + i);
          S[i] = dA * S[i] + coef * bv.x; S[i + 1] = dA * S[i + 1] + coef * bv.y;
          S[i + 2] = dA * S[i + 2] + coef * bv.z; S[i + 3] = dA * S[i + 3] + coef * bv.w;
        }
      } else {
        f32x2_t ya = {0.f, 0.f}, yb = {0.f, 0.f};
#pragma unroll
        for (int i = 0; i < 16; i += 4) {
          float4 bv = *(const float4*)(Bs + tt * 64 + nq * 16 + i);
          float4 cv = *(const float4*)(Cs + tt * 64 + nq * 16 + i);
          f32x2_t s01 = {S[i], S[i + 1]}, s23 = {S[i + 2], S[i + 3]};
          f32x2_t b01 = {bv.x, bv.y}, b23 = {bv.z, bv.w}, c01 = {cv.x, cv.y}, c23 = {cv.z, cv.w};
          s01 = dA * s01 + coef * b01; s23 = dA * s23 + coef * b23;
          ya += s01 * c01; yb += s23 * c23;
          S[i] = s01.x; S[i + 1] = s01.y; S[i + 2] = s23.x; S[i + 3] = s23.y;
        }
        float y = (ya.x + ya.y) + (yb.x + yb.y);
        y = quad_sum(y);
        if (nq == 0) Yd[(size_t)(rowb + t0 + tt) * 256 + h * 64 + pp] = y + Dk * xv;
      }
    }
  }
  if (mode == 1) {
    float* sl = SLOC + (size_t)seg * 4096;
#pragma unroll
    for (int i = 0; i < 16; ++i) sl[i] = S[i];
    if (lt == 0) SDEC[seg] = __expf(a * dsum);
  }
  if (mode == 0) {
    float* so = p.out + O_BSSM + ((((size_t)(b * 2 + l) * 2 + dir) * 4 + h) * 64 + pp) * 64 + nq * 16;
#pragma unroll
    for (int i = 0; i < 16; ++i) so[i] = S[i];
  }
  if (mode != 1) {
    asm volatile("s_waitcnt vmcnt(0)" ::: "memory");
    __syncthreads();
    const float* YF = (const float*)(p.ws + WS_YF); const float* YB = (const float*)(p.ws + WS_YB);
    u16* MIX = (u16*)(p.ws + WS_H);
    const int lane = tid & 63, wave = tid >> 6;
    const float gn = p.in[27][l * 256 + h * 64 + lane];
    for (int t0 = tbeg + wave * 4; t0 < tbeg + tlen; t0 += 32) {
      float ya[4], yb[4], zz[4];
#pragma unroll
      for (int u = 0; u < 4; ++u) {
        const size_t row = (size_t)(rowb + t0 + u);
        ya[u] = YF[row * 256 + h * 64 + lane]; yb[u] = YB[row * 256 + h * 64 + lane];
        zz[u] = bf2f(PROJ[row * NINP + C_BZ + h * 64 + lane]);
      }
#pragma unroll
      for (int u = 0; u < 4; ++u) {
        const size_t row = (size_t)(rowb + t0 + u);
        float v = (ya[u] + yb[u]) * siluf(zz[u]);
        float ms = wave_sum(v * v) * (1.f / 64.f);
        MIX[row * 1024 + 256 + h * 64 + lane] = f2bf(v * rsqrtf(ms + EPS_F) * gn);
      }
    }
  }
  __syncthreads();
}

DEV void gla_item(const Params& p, int l, int grp, int b, int h, int mode, int seg) {
  const int TIDX = ltid();
  LDS_DECL;
  const int tid = TIDX, dir = tid >> 8, lt = tid & 255, vv = lt >> 2, kq = lt & 3;
  float* base = (float*)lds_raw + dir * (4 * 2048 + (32 * 192) / 2);
  float* fs = base; float* ks = base + 2048; float* qs = base + 4096; float* vs = base + 6144;
  u16* graw = (u16*)(base + 8192);
  const u16* PROJ = (const u16*)(p.ws + WS_R1);
  float* Od = (float*)(p.ws + (dir ? WS_OB : WS_OF));
  const int T = grp ? 4096 : 256;
  const int rowb = grp ? MP + b * 4096 : b * 256;
  float S[16], Fp[16];
  float* GLOC = (float*)(p.ws + WS_GSLOC) + ((size_t)((b * 4 + h) * 2 + dir) * NSEG) * 4096 + (size_t)(kq * 16) * 64 + vv;
  float* GDEC = (float*)(p.ws + WS_GDEC) + ((size_t)((b * 4 + h) * 2 + dir) * NSEG) * 64 + kq * 16;
#pragma unroll
  for (int i = 0; i < 16; ++i) Fp[i] = 1.f;
  if (mode == 2) {
    const float* s0 = p.in[5] + ((((size_t)(b * 2 + l) * 2 + dir) * 4 + h) * 64) * 64;
#pragma unroll
    for (int i = 0; i < 16; ++i) S[i] = s0[(size_t)(kq * 16 + i) * 64 + vv];
    const int npre = dir ? NSEG - 1 - seg : seg;
    for (int q = 0; q < npre; ++q) {
      const int sg = dir ? NSEG - 1 - q : q;
      const float* sl = GLOC + (size_t)sg * 4096;
      const float* fd = GDEC + sg * 64;
#pragma unroll
      for (int i = 0; i < 16; ++i) S[i] = fd[i] * S[i] + sl[(size_t)i * 64];
    }
  } else {
#pragma unroll
    for (int i = 0; i < 16; ++i) S[i] = 0.f;
  }
  const int tbeg = (mode == 0) ? 0 : seg * SEGLEN;
  const int tlen = (mode == 0) ? T : SEGLEN;
  float lbv = 0.f;
  {
    int k = lt & 63;
    if (l == 1) {
      float l0 = p.in[28][(0 * 2 + dir) * 256 + h * 64 + k], l1 = p.in[28][(1 * 2 + dir) * 256 + h * 64 + k];
      lbv = 1.f / (1.f + __expf(l0 - l1));
    }
  }
  const int nch = tlen / 32;
  uint4 gpre0, gpre1, gpre2;
#define GLA_FETCH(ci_) do { \
    const int c_ = dir ? nch - 1 - (ci_) : (ci_); \
    const int t0_ = tbeg + c_ * 32; \
    _Pragma("unroll") \
    for (int i = 0; i < 3; ++i) { \
      const int e = lt + i * 256; \
      int tt = e / 24, q = e % 24, which = q >> 3, c8 = (q & 7) * 8; \
      int col = (which == 0) ? C_CF + dir * 256 + h * 64 + c8 : (which == 1 ? C_CQ + h * 64 + c8 : C_CI + h * 64 + c8); \
      const uint4 v = *(const uint4*)(PROJ + (size_t)(rowb + t0_ + tt) * NINP + col); \
      if (i == 0) gpre0 = v; else if (i == 1) gpre1 = v; else gpre2 = v; \
    } \
  } while (0)
  GLA_FETCH(0);
  for (int ci = 0; ci < nch; ++ci) {
    const int c = dir ? nch - 1 - ci : ci;
    const int t0 = tbeg + c * 32;
    __syncthreads();
#pragma unroll
    for (int i = 0; i < 3; ++i) {
      const int e = lt + i * 256;
      int tt = e / 24, q = e % 24;
      *(uint4*)(graw + tt * 192 + (q >> 3) * 64 + (q & 7) * 8) = (i == 0) ? gpre0 : (i == 1) ? gpre1 : gpre2;
    }
    __syncthreads();
    if (ci + 1 < nch) GLA_FETCH(ci + 1);
    for (int e = lt; e < 32 * 64; e += 256) {
      int tt = e >> 6, k = e & 63;
      float fr = bf2f(graw[tt * 192 + k]);
      float f = lbv + (1.f - lbv) * sigmf(fr);
      fs[e] = fmaxf(f, 1e-6f);
      ks[e] = (1.f - lbv) * sigmf(-fr);
      qs[e] = bf2f(graw[tt * 192 + 64 + k]);
      vs[e] = bf2f(graw[tt * 192 + 128 + k]);
    }
    __syncthreads();
#pragma unroll 4
    for (int s = 0; s < 32; ++s) {
      const int tt = dir ? 31 - s : s;
      float vt = vs[tt * 64 + vv];
      if (mode == 1) {
#pragma unroll
        for (int i = 0; i < 16; i += 4) {
          float4 f4 = *(const float4*)(fs + tt * 64 + kq * 16 + i);
          float4 k4 = *(const float4*)(ks + tt * 64 + kq * 16 + i);
          S[i] = f4.x * S[i] + k4.x * vt; S[i + 1] = f4.y * S[i + 1] + k4.y * vt;
          S[i + 2] = f4.z * S[i + 2] + k4.z * vt; S[i + 3] = f4.w * S[i + 3] + k4.w * vt;
          Fp[i] *= f4.x; Fp[i + 1] *= f4.y; Fp[i + 2] *= f4.z; Fp[i + 3] *= f4.w;
        }
      } else {
        f32x2_t oa = {0.f, 0.f}, ob2 = {0.f, 0.f};
#pragma unroll
        for (int i = 0; i < 16; i += 4) {
          float4 f4 = *(const float4*)(fs + tt * 64 + kq * 16 + i);
          float4 k4 = *(const float4*)(ks + tt * 64 + kq * 16 + i);
          float4 q4 = *(const float4*)(qs + tt * 64 + kq * 16 + i);
          f32x2_t s01 = {S[i], S[i + 1]}, s23 = {S[i + 2], S[i + 3]};
          f32x2_t f01 = {f4.x, f4.y}, f23 = {f4.z, f4.w}, k01 = {k4.x, k4.y}, k23 = {k4.z, k4.w}, q01 = {q4.x, q4.y}, q23 = {q4.z, q4.w};
          s01 = f01 * s01 + k01 * vt; s23 = f23 * s23 + k23 * vt;
          oa += s01 * q01; ob2 += s23 * q23;
          S[i] = s01.x; S[i + 1] = s01.y; S[i + 2] = s23.x; S[i + 3] = s23.y;
        }
        float o = (oa.x + oa.y) + (ob2.x + ob2.y);
        o = quad_sum(o);
        if (kq == 0) Od[(size_t)(rowb + t0 + tt) * 256 + h * 64 + vv] = o;
      }
    }
  }
  if (mode == 1) {
    float* sl = GLOC + (size_t)seg * 4096;
#pragma unroll
    for (int i = 0; i < 16; ++i) sl[(size_t)i * 64] = S[i];
    if (vv == 0) {
#pragma unroll
      for (int i = 0; i < 16; ++i) GDEC[seg * 64 + i] = Fp[i];
    }
  }
  if (mode == 0) {
    float* so = p.out + O_CH + ((((size_t)(b * 2 + l) * 2 + dir) * 4 + h) * 64) * 64;
#pragma unroll
    for (int i = 0; i < 16; ++i) so[(size_t)(kq * 16 + i) * 64 + vv] = S[i];
  }
  if (mode != 1) {
    asm volatile("s_waitcnt vmcnt(0)" ::: "memory");
    __syncthreads();
    const float* OF = (const float*)(p.ws + WS_OF); const float* OB = (const float*)(p.ws + WS_OB);
    u16* MIX = (u16*)(p.ws + WS_H);
    const int lane = tid & 63, wave = tid >> 6;
    const float gn = p.in[29][l * 256 + h * 64 + lane];
    for (int t0 = tbeg + wave * 4; t0 < tbeg + tlen; t0 += 32) {
      float oa[4], ob[4], gg[4];
#pragma unroll
      for (int u = 0; u < 4; ++u) {
        const size_t row = (size_t)(rowb + t0 + u);
        oa[u] = OF[row * 256 + h * 64 + lane]; ob[u] = OB[row * 256 + h * 64 + lane];
        gg[u] = bf2f(PROJ[row * NINP + C_CG + h * 64 + lane]);
      }
#pragma unroll
      for (int u = 0; u < 4; ++u) {
        const size_t row = (size_t)(rowb + t0 + u);
        float o = oa[u] + ob[u];
        float ms = wave_sum(o * o) * (1.f / 64.f);
        MIX[row * 1024 + 512 + h * 64 + lane] = f2bf(o * rsqrtf(ms + EPS_F) * gn * siluf(gg[u]));
      }
    }
  }
  __syncthreads();
}

DEV void scanA_phase(const Params& p, int l) {
  for (int it = (int)gridDim.x - 1 - (int)blockIdx.x; it < 256; it += gridDim.x) {
    int v = it & 127;
    if (it < 128) ssd_item(p, l, 1, v >> 6, (v >> 4) & 3, 1, v & 15);
    else gla_item(p, l, 1, v >> 6, (v >> 4) & 3, 1, v & 15);
  }
}

DEV void mix_phase(const Params& p, int l) {
  const int TIDX = ltid();
  LDS_DECL;
  unsigned* ctr = (unsigned*)(p.ws + WS_CTL) + l;
  volatile int* slot = (volatile int*)(lds_raw + LDS_BYTES - 16);
  bool first = true;
  for (;;) {
    int it;
    if (first) {
      it = (int)blockIdx.x; first = false;
    } else {
      __syncthreads();
      if (TIDX == 0) *slot = (int)atomicAdd(ctr, 1u) + (int)gridDim.x;
      __syncthreads();
      it = *slot;
      __syncthreads();
    }
    if (it >= 1024) break;
    if (it < 128) attnA_item(p, 1, it >> 6, (it >> 4) & 3, it & 15);
    else if (it < 256) { it -= 128; gla_item(p, l, 1, it >> 6, (it >> 4) & 3, 2, it & 15); }
    else if (it < 384) { it -= 256; ssd_item(p, l, 1, it >> 6, (it >> 4) & 3, 2, it & 15); }
    else if (it < 512) { it -= 384; attnD_item(p, l, 1, it >> 6, (it >> 4) & 3, it & 15); }
    else if (it < 640) { it -= 512; gla_item(p, l, 0, it >> 2, it & 3, 0, 0); }
    else if (it < 768) { it -= 640; ssd_item(p, l, 0, it >> 2, it & 3, 0, 0); }
    else if (it < 896) { it -= 768; attnA_item(p, 0, it >> 2, it & 3, 0); }
    else { it -= 896; attnD_item(p, l, 0, it >> 2, it & 3, 0); }
  }
}

DEV void ffn_gu(int f) { gemm_phase<EPI_SWIGLU>(WS_H, WS_WGU + f * SZ_WGU1, MTOT, NGU, DM, 0, 0.f); }
DEV void ffn_down(int l, int f) { gemm_phase<EPI_RESID>(WS_R1, WS_WDN + f * SZ_WDN1, MTOT, DM, DFF, (size_t)(l * 3 * 9216 + (f ? 2 : 0) * 3072 + 2048), 0.5f); }
DEV void win_gemm() { gemm_phase<EPI_PROJ>(WS_H, WS_WIN, MTOT, NINP, DM, 0, 0.f); }
DEV void wout_gemm(int l) { gemm_phase<EPI_RESID>(WS_H, WS_WOUT, MTOT, DM, DM, (size_t)(l * 3 * 9216 + 1 * 3072 + 2048), 1.0f); }

DEV void finalize_phase(const Params& p, int l) {
  const int TIDX = ltid();
  const int lane = TIDX & 63, wave = TIDX >> 6;
  const u16* PROJ = (const u16*)(p.ws + WS_R1);
  const float* YF = (const float*)(p.ws + WS_YF); const float* YB = (const float*)(p.ws + WS_YB);
  const float* OF = (const float*)(p.ws + WS_OF); const float* OB = (const float*)(p.ws + WS_OB);
  u16* MIX = (u16*)(p.ws + WS_H);
  const int tstride = gridDim.x * 8;
  for (int tsk0 = blockIdx.x * 8 + wave; tsk0 < MTOT * 8; tsk0 += 4 * tstride) {
    float a[4], bq[4], gz[4];
#pragma unroll
    for (int u = 0; u < 4; ++u) {
      const int tsk = tsk0 + u * tstride;
      a[u] = 0.f; bq[u] = 0.f; gz[u] = 0.f;
      if (tsk < MTOT * 8) {
        const size_t row = (size_t)(tsk >> 3);
        const int h = tsk & 3, isC = (tsk >> 2) & 1;
        const float* F = isC ? OF : YF; const float* Bk = isC ? OB : YB;
        a[u] = F[row * 256 + h * 64 + lane]; bq[u] = Bk[row * 256 + h * 64 + lane];
        gz[u] = bf2f(PROJ[row * NINP + (isC ? C_CG : C_BZ) + h * 64 + lane]);
      }
    }
#pragma unroll
    for (int u = 0; u < 4; ++u) {
      const int tsk = tsk0 + u * tstride;
      if (tsk < MTOT * 8) {
        const size_t row = (size_t)(tsk >> 3);
        const int h = tsk & 3, isC = (tsk >> 2) & 1;
        if (!isC) {
          float v = (a[u] + bq[u]) * siluf(gz[u]);
          float ms = wave_sum(v * v) * (1.f / 64.f);
          MIX[row * 1024 + 256 + h * 64 + lane] = f2bf(v * rsqrtf(ms + EPS_F) * p.in[27][l * 256 + h * 64 + lane]);
        } else {
          float o = a[u] + bq[u];
          float ms = wave_sum(o * o) * (1.f / 64.f);
          MIX[row * 1024 + 512 + h * 64 + lane] = f2bf(o * rsqrtf(ms + EPS_F) * p.in[29][l * 256 + h * 64 + lane] * siluf(gz[u]));
        }
      }
    }
  }
}

typedef __attribute__((address_space(1))) unsigned gu32;
struct XcdBar { unsigned xcc, nloc, nx; };
DEV gu32* xb_word(unsigned byteoff) { return (gu32*)(getp().ws + WS_CTL + byteoff); }
DEV unsigned xb_ld(gu32* p) { return __hip_atomic_load(p, __ATOMIC_RELAXED, __HIP_MEMORY_SCOPE_AGENT); }
DEV unsigned xb_add(gu32* p, unsigned v) { return __hip_atomic_fetch_add(p, v, __ATOMIC_RELAXED, __HIP_MEMORY_SCOPE_AGENT); }
constexpr unsigned XB_XCNT = 1024, XB_XSUB = 2048, XB_TOP = 3072, XB_TOPGEN = 3200, XB_XGEN = 3328;
DEV XcdBar xcd_census() {
  LDS_DECL;
  volatile unsigned* st = (volatile unsigned*)(lds_raw + LDS_BYTES - 64);
  XcdBar b;
  if (threadIdx.x == 0) {
    const unsigned xcc = ((unsigned)__builtin_amdgcn_s_getreg((3 << 11) | 20)) & 7u;
    (void)xb_add(xb_word(XB_XCNT + xcc * 128), 1u);
    unsigned sum = 0u, cnt = 0u, mine = 0u;
    for (unsigned sp = 0; sp < (1u << 20); ++sp) {
      sum = 0u; cnt = 0u; mine = 0u;
#pragma unroll
      for (unsigned j = 0; j < 8; ++j) { const unsigned c = xb_ld(xb_word(XB_XCNT + j * 128)); sum += c; cnt += (c > 0u) ? 1u : 0u; mine = (j == xcc) ? c : mine; }
      if (sum == gridDim.x) break;
      __builtin_amdgcn_s_sleep(2);
    }
    st[0] = xcc; st[1] = mine > 0u ? mine : 1u; st[2] = cnt > 0u ? cnt : 1u;
  }
  __syncthreads();
  b.xcc = __builtin_amdgcn_readfirstlane(st[0]);
  b.nloc = __builtin_amdgcn_readfirstlane(st[1]);
  b.nx = __builtin_amdgcn_readfirstlane(st[2]);
  __syncthreads();
  return b;
}
DEV void grid_bar(unsigned& epoch, const XcdBar& b) {
  ++epoch;
  asm volatile("s_waitcnt vmcnt(0)" ::: "memory");
  __syncthreads();
  if (threadIdx.x == 0) {
    __builtin_amdgcn_s_waitcnt(0);
    const unsigned old = xb_add(xb_word(XB_XSUB + b.xcc * 128), 1u);
    if (old + 1u == epoch * b.nloc) {
      __builtin_amdgcn_fence(__ATOMIC_RELEASE, "agent");
      asm volatile("s_waitcnt vmcnt(0)" ::: "memory");
      const unsigned og = xb_add(xb_word(XB_TOP), 1u);
      if (og + 1u == epoch * b.nx) __hip_atomic_store(xb_word(XB_TOPGEN), epoch, __ATOMIC_RELAXED, __HIP_MEMORY_SCOPE_AGENT);
      else { for (unsigned sp = 0; sp < (1u << 22) && xb_ld(xb_word(XB_TOPGEN)) < epoch; ++sp) __builtin_amdgcn_s_sleep(1); }
      __builtin_amdgcn_fence(__ATOMIC_ACQUIRE, "agent");
      __hip_atomic_store(xb_word(XB_XGEN + b.xcc * 64), epoch, __ATOMIC_RELAXED, __HIP_MEMORY_SCOPE_AGENT);
      asm volatile("s_waitcnt vmcnt(0)" ::: "memory");
    } else {
      for (unsigned sp = 0; sp < (1u << 22) && xb_ld(xb_word(XB_XGEN + b.xcc * 64)) < epoch; ++sp) __builtin_amdgcn_s_sleep(1);
      __builtin_amdgcn_fence(__ATOMIC_ACQUIRE, "agent");
      asm volatile("s_waitcnt vmcnt(0)" ::: "memory");
    }
  }
  __syncthreads();
}

#ifndef MEGA
#define MEGA 1
#endif
#if MEGA
template <int L>
DEV void layer_body(unsigned& ep, const XcdBar& xb) {
  ffn_gu(0);
  grid_bar(ep, xb);
  ffn_down(L, 0);
  grid_bar(ep, xb);
  ln_phase(getp(), L, 0);
  grid_bar(ep, xb);
  win_gemm();
  grid_bar(ep, xb);
  prep_phase(getp(), L);
  scanA_phase(getp(), L);
  grid_bar(ep, xb);
  mix_phase(getp(), L);
  grid_bar(ep, xb);
  wout_gemm(L);
  grid_bar(ep, xb);
  ln_phase(getp(), L, 1);
  grid_bar(ep, xb);
  ffn_gu(1);
  grid_bar(ep, xb);
  ffn_down(L, 1);
  grid_bar(ep, xb);
  ln_phase(getp(), L, 2);
}

__global__ void __launch_bounds__(NTH) trunk_megakernel(Params pk) {
  cg::grid_group grid = cg::this_grid();
  if (blockIdx.x == 0) { for (int i = threadIdx.x; i < 1024; i += NTH) ((unsigned*)(getp().ws + WS_CTL))[i] = 0u; }
  mod_phase(getp());
  conv_phase(getp(), 0);
  grid.sync();
  const XcdBar xb = xcd_census();
  unsigned ep = 0;
  init_phase(getp());
  grid_bar(ep, xb);
  layer_body<0>(ep, xb);
  conv_phase(getp(), 1);
  grid_bar(ep, xb);
  layer_body<1>(ep, xb);
}

extern "C" void kernel_launch(void* const* d_in, const int* in_sizes, int n_in, void* d_out, int out_size, void* d_ws,
                              size_t ws_size, hipStream_t stream) {
  static int grid_blocks = 0;
  if (!grid_blocks) {
    int dev = 0, cus = 0, per_cu = 0;
    (void)hipGetDevice(&dev);
    (void)hipDeviceGetAttribute(&cus, hipDeviceAttributeMultiprocessorCount, dev);
    (void)hipFuncSetAttribute((const void*)trunk_megakernel, hipFuncAttributeMaxDynamicSharedMemorySize, LDS_BYTES);
    (void)hipOccupancyMaxActiveBlocksPerMultiprocessor(&per_cu, (const void*)trunk_megakernel, NTH, LDS_BYTES);
    if (per_cu < 1) per_cu = 1;
    grid_blocks = cus * per_cu;
    if (ws_size < WS_END) fprintf(stderr, "workspace too small: %zu < %zu\n", ws_size, (size_t)WS_END);
  }
  Params p{};
  for (int i = 0; i < 31; ++i) p.in[i] = (const float*)d_in[i];
  p.out = (float*)d_out;
  p.ws = (unsigned char*)d_ws;
  void* args[] = {&p};
  hipError_t e = hipLaunchCooperativeKernel((const void*)trunk_megakernel, dim3(grid_blocks), dim3(NTH), args, LDS_BYTES, stream);
  if (e != hipSuccess) fprintf(stderr, "cooperative launch failed: %s (grid %d)\n", hipGetErrorString(e), grid_blocks);
}
#else
enum { PH_START = 0, PH_INIT, PH_GU, PH_DOWN, PH_LN, PH_WIN, PH_PREP, PH_MIX, PH_WOUT, PH_CONV1, PH_FIN };
template <int PH, int L, int F>
__global__ void __launch_bounds__(NTH) k_phase(Params pk) {
  if (PH == PH_START) {
    if (blockIdx.x == 0 && threadIdx.x < 16) ((unsigned*)(getp().ws + WS_CTL))[threadIdx.x] = 0u;
    mod_phase(getp());
    conv_phase(getp(), 0);
  } else if (PH == PH_INIT) init_phase(getp());
  else if (PH == PH_GU) ffn_gu(F);
  else if (PH == PH_DOWN) ffn_down(L, F);
  else if (PH == PH_LN) ln_phase(getp(), L, F);
  else if (PH == PH_WIN) win_gemm();
  else if (PH == PH_PREP) { prep_phase(getp(), L); scanA_phase(getp(), L); }
  else if (PH == PH_MIX) mix_phase(getp(), L);
  else if (PH == PH_FIN) finalize_phase(getp(), L);
  else if (PH == PH_WOUT) wout_gemm(L);
  else if (PH == PH_CONV1) conv_phase(getp(), 1);
}
template <int PH, int L, int F>
static void launch_phase(const Params& p, hipStream_t stream) {
  static bool attr = false;
  if (!attr) { (void)hipFuncSetAttribute((const void*)k_phase<PH, L, F>, hipFuncAttributeMaxDynamicSharedMemorySize, LDS_BYTES); attr = true; }
  hipLaunchKernelGGL((k_phase<PH, L, F>), dim3(256), dim3(NTH), LDS_BYTES, stream, p);
}
template <int L>
static void launch_layer(const Params& p, hipStream_t s) {
  launch_phase<PH_GU, L, 0>(p, s);
  launch_phase<PH_DOWN, L, 0>(p, s);
  launch_phase<PH_LN, L, 0>(p, s);
  launch_phase<PH_WIN, L, 0>(p, s);
  launch_phase<PH_PREP, L, 0>(p, s);
  launch_phase<PH_MIX, L, 0>(p, s);
  launch_phase<PH_FIN, L, 0>(p, s);
  launch_phase<PH_WOUT, L, 0>(p, s);
  launch_phase<PH_LN, L, 1>(p, s);
  launch_phase<PH_GU, L, 1>(p, s);
  launch_phase<PH_DOWN, L, 1>(p, s);
  launch_phase<PH_LN, L, 2>(p, s);
}
extern "C" void kernel_launch(void* const* d_in, const int* in_sizes, int n_in, void* d_out, int out_size, void* d_ws,
                              size_t ws_size, hipStream_t stream) {
  if (ws_size < WS_END) fprintf(stderr, "workspace too small: %zu < %zu\n", ws_size, (size_t)WS_END);
  Params p{};
  for (int i = 0; i < 31; ++i) p.in[i] = (const float*)d_in[i];
  p.out = (float*)d_out;
  p.ws = (unsigned char*)d_ws;
  launch_phase<PH_START, 0, 0>(p, stream);
  launch_phase<PH_INIT, 0, 0>(p, stream);
  launch_layer<0>(p, stream);
  launch_phase<PH_CONV1, 0, 0>(p, stream);
  launch_layer<1>(p, stream);
}
#endif
```

```cpp
#include <hip/hip_runtime.h>
#include <hip/hip_cooperative_groups.h>
#include <cstdio>
namespace cg = cooperative_groups;

typedef unsigned short u16;
using bf16x8 = __attribute__((ext_vector_type(8))) short;
using f32x4 = __attribute__((ext_vector_type(4))) float;
#define DEV __device__ __forceinline__
#define LDS_DECL extern __shared__ __attribute__((aligned(16))) unsigned char lds_raw[]

constexpr int NTH = 512;
constexpr int DM = 1024, DFF = 2816, NGU = 5632, NIN = 2920, NINP = 3072, MTOT = 16384, MP = 8192;
constexpr float ALPHA_F = 1.41421356237309515f;
constexpr float LOG2E = 1.44269504088896341f;
constexpr float EPS_F = 1e-6f;
constexpr int LDS_BYTES = 131072;

constexpr int C_ACQ = 0, C_ACKV = 192, C_AKR = 320, C_BZ = 352, C_BXBC = 608, C_BDT = 1120, C_CQ = 1128, C_CF = 1384,
              C_CI = 1896, C_CG = 2152, C_DQ = 2408, C_DK = 2664, C_DV = 2792;
constexpr size_t O_YP = 0, O_YS = 8388608, O_CKV = 16777216, O_KR = 18874368, O_BSSM = 19398656, O_CH = 21495808,
                 O_DK = 23592960, O_DV = 25690112;
constexpr size_t WS_CTL = 0;
constexpr size_t WS_MOD = 4096;
constexpr size_t WS_WGU = 262144;
constexpr size_t SZ_WGU1 = (size_t)NGU * DM * 2;
constexpr size_t WS_WDN = WS_WGU + 2 * SZ_WGU1;
constexpr size_t SZ_WDN1 = (size_t)DM * DFF * 2;
constexpr size_t WS_WIN = WS_WDN + 2 * SZ_WDN1;
constexpr size_t WS_WOUT = WS_WIN + (size_t)NINP * DM * 2;
constexpr size_t WS_X = WS_WOUT + (size_t)DM * DM * 2;
constexpr size_t WS_H = WS_X + (size_t)MTOT * DM * 4;
constexpr size_t WS_R1 = WS_H + (size_t)MTOT * DM * 2;
constexpr size_t WS_QA = WS_R1 + (size_t)MTOT * NINP * 2;
constexpr int KAROWS = 8192 + 2 * 4608;
constexpr size_t WS_KA = WS_QA + (size_t)MTOT * 384 * 2;
constexpr size_t WS_VA = WS_KA + (size_t)KAROWS * 384 * 2;
constexpr size_t WS_QD = WS_VA + (size_t)KAROWS * 256 * 2;
constexpr size_t WS_KD = WS_QD + (size_t)MTOT * 256 * 2;
constexpr size_t WS_YF = WS_KD + (size_t)MTOT * 128 * 2;
constexpr size_t WS_YB = WS_YF + (size_t)MTOT * 256 * 4;
constexpr size_t WS_OF = WS_YB + (size_t)MTOT * 256 * 4;
constexpr size_t WS_OB = WS_OF + (size_t)MTOT * 256 * 4;
constexpr int NSEG = 16, SEGLEN = 256;
constexpr size_t WS_SSLOC = WS_OB + (size_t)MTOT * 256 * 4;
constexpr size_t WS_GSLOC = WS_SSLOC + (size_t)2 * 4 * 2 * NSEG * 4096 * 4;
constexpr size_t WS_SDEC = WS_GSLOC + (size_t)2 * 4 * 2 * NSEG * 4096 * 4;
constexpr size_t WS_GDEC = WS_SDEC + 4096;
constexpr size_t WS_WUQ = WS_GDEC + (size_t)2 * 4 * 2 * NSEG * 64 * 4;
constexpr size_t WS_WUKV = WS_WUQ + (size_t)384 * 192 * 2;
constexpr size_t WS_END = WS_WUKV + (size_t)512 * 128 * 2;

struct Params {
  const float* in[31];
  float* out;
  unsigned char* ws;
};

typedef const __attribute__((address_space(4))) Params* KParamsPtr;
template <typename T>
DEV T* uni_ptr(T* p) {
  unsigned long long v = (unsigned long long)p;
  unsigned lo = __builtin_amdgcn_readfirstlane((unsigned)v), hi = __builtin_amdgcn_readfirstlane((unsigned)(v >> 32));
  return (T*)(((unsigned long long)hi << 32) | lo);
}
DEV Params getp() {
  Params r;
#if defined(__HIP_DEVICE_COMPILE__)
  KParamsPtr k;
  {
    unsigned long long v = (unsigned long long)__builtin_amdgcn_kernarg_segment_ptr();
    unsigned lo = __builtin_amdgcn_readfirstlane((unsigned)v), hi = __builtin_amdgcn_readfirstlane((unsigned)(v >> 32));
    k = (KParamsPtr)(((unsigned long long)hi << 32) | lo);
  }
#pragma unroll
  for (int i = 0; i < 31; ++i) r.in[i] = k->in[i];
  r.out = k->out;
  r.ws = k->ws;
#else
  r = Params{};
#endif
  return r;
}
DEV float bf2f(u16 u) { return __uint_as_float(((unsigned)u) << 16); }
typedef __attribute__((ext_vector_type(2))) float f32x2_t;
typedef __attribute__((ext_vector_type(2))) __bf16 bf16x2_t;
DEV unsigned pack2(float a, float b) {
  f32x2_t v = {a, b};
  return __builtin_bit_cast(unsigned, __builtin_convertvector(v, bf16x2_t));
}
DEV u16 f2bf(float f) { return (u16)(pack2(f, 0.f) & 0xffffu); }
DEV float siluf(float x) { return x * __builtin_amdgcn_rcpf(1.f + __expf(-x)); }
DEV float sigmf(float x) { return __builtin_amdgcn_rcpf(1.f + __expf(-x)); }
DEV float wave_sum(float v) {
  v += __builtin_bit_cast(float, __builtin_amdgcn_mov_dpp(__builtin_bit_cast(int, v), 0xB1, 0xF, 0xF, true));
  v += __builtin_bit_cast(float, __builtin_amdgcn_mov_dpp(__builtin_bit_cast(int, v), 0x4E, 0xF, 0xF, true));
  v += __builtin_bit_cast(float, __builtin_amdgcn_mov_dpp(__builtin_bit_cast(int, v), 0x141, 0xF, 0xF, true));
  v += __builtin_bit_cast(float, __builtin_amdgcn_mov_dpp(__builtin_bit_cast(int, v), 0x140, 0xF, 0xF, true));
  v += __shfl_xor(v, 16);
  v += __shfl_xor(v, 32);
  return v;
}
DEV int ltid() { int z = 0; asm volatile("" : "+v"(z)); return (int)threadIdx.x + z; }
DEV float quad_sum(float v) {
  v += __builtin_bit_cast(float, __builtin_amdgcn_mov_dpp(__builtin_bit_cast(int, v), 0xB1, 0xF, 0xF, true));
  v += __builtin_bit_cast(float, __builtin_amdgcn_mov_dpp(__builtin_bit_cast(int, v), 0x4E, 0xF, 0xF, true));
  return v;
}
DEV int row_mi(int row) { return row < MP ? 0 : 1 + ((row - MP) >> 12); }

DEV void mod_phase(const Params& p) {
  const int TIDX = ltid();
  LDS_DECL;
  float* sc = (float*)lds_raw;
  float* red = sc + 3 * 1024;
  const int tid = TIDX;
  const float* cl = p.in[8];
  const float* cc = p.in[9];
  for (int i = tid; i < 3072; i += NTH) {
    int m = i >> 10, k = i & 1023;
    float v = (m == 0) ? cc[k] : cl[(m - 1) * 1024 + k];
    sc[i] = siluf(v);
  }
  __syncthreads();
  float* MOD = (float*)(p.ws + WS_MOD);
  const float* wm = p.in[10];
  const float* bm = p.in[11];
  const int col = tid % 72, kp = tid / 72;
  float* red72 = sc + 3 * 1024;
  for (int u = blockIdx.x; u < 256; u += gridDim.x) {
    int l = u >> 7, j0 = (u & 127) * 72;
    float a0 = 0.f, a1 = 0.f, a2 = 0.f;
    if (kp < 7) {
      const int k0 = kp * 147, k1 = min(1024, k0 + 147);
      const float* w = wm + ((size_t)l * 1024 + k0) * 9216 + j0 + col;
#pragma unroll 7
      for (int k = k0; k < k1; ++k) {
        float wv = w[(size_t)(k - k0) * 9216];
        a0 += sc[k] * wv; a1 += sc[1024 + k] * wv; a2 += sc[2048 + k] * wv;
      }
      red72[(kp * 3 + 0) * 72 + col] = a0; red72[(kp * 3 + 1) * 72 + col] = a1; red72[(kp * 3 + 2) * 72 + col] = a2;
    }
    __syncthreads();
    if (tid < 216) {
      int m = tid / 72, c = tid % 72;
      float s = bm[l * 9216 + j0 + c];
#pragma unroll
      for (int q = 0; q < 7; ++q) s += red72[(q * 3 + m) * 72 + c];
      MOD[(l * 3 + m) * 9216 + j0 + c] = s;
    }
    __syncthreads();
  }
}

DEV void conv_decode(const Params& p, int l, int u, const float*& src, int& K, int& Nsrc, u16*& dst, int& kt, int& nt, bool& perm) {
  int v = u;
  if (v < 2816) {
    int f = v / 1408; v %= 1408;
    src = p.in[14] + ((size_t)(l * 2 + f)) * DM * NGU; K = DM; Nsrc = NGU; dst = (u16*)(p.ws + WS_WGU + f * SZ_WGU1); kt = v % 16; nt = v / 16; perm = true;
  } else if (v < 4224) {
    v -= 2816; int f = v / 704; v %= 704;
    src = p.in[15] + ((size_t)(l * 2 + f)) * DFF * DM; K = DFF; Nsrc = DM; dst = (u16*)(p.ws + WS_WDN + f * SZ_WDN1); kt = v % 44; nt = v / 44; perm = false;
  } else if (v < 4992) {
    v -= 4224;
    src = p.in[16] + (size_t)l * DM * NIN; K = DM; Nsrc = NIN; dst = (u16*)(p.ws + WS_WIN); kt = v % 16; nt = v / 16; perm = false;
  } else if (v < 5248) {
    v -= 4992;
    src = p.in[17] + (size_t)l * DM * DM; K = DM; Nsrc = DM; dst = (u16*)(p.ws + WS_WOUT); kt = v % 16; nt = v / 16; perm = false;
  } else if (v < 5266) {
    v -= 5248;
    src = p.in[20] + (size_t)l * 192 * 384; K = 192; Nsrc = 384; dst = (u16*)(p.ws + WS_WUQ); kt = v % 3; nt = v / 3; perm = false;
  } else {
    v -= 5266; if (v > 15) v = 15;
    src = p.in[21] + (size_t)l * 128 * 512; K = 128; Nsrc = 512; dst = (u16*)(p.ws + WS_WUKV); kt = v % 2; nt = v / 2; perm = false;
  }
}
DEV void conv_phase(const Params& p, int l) {
  const int TIDX = ltid();
  LDS_DECL;
  float* tb = (float*)lds_raw;
  const int tid = TIDX;
  for (int g = (int)gridDim.x - 1 - (int)blockIdx.x; g < 1321; g += gridDim.x) {
    __syncthreads();
#pragma unroll 1
    for (int q = 0; q < 4; ++q) {
      const float* src; int K, Nsrc, kt, nt; u16* dst; bool perm;
      conv_decode(p, l, g * 4 + q, src, K, Nsrc, dst, kt, nt, perm);
      float* t = tb + q * (64 * 65);
#pragma unroll
      for (int i = 0; i < 2; ++i) {
        int e = tid + i * NTH; int kk = e >> 4, nn = (e & 15) * 4;
        int np = nt * 64 + nn;
        int sc_ = np;
        if (perm) { int blk = np >> 5, w = np & 31; sc_ = (w < 16) ? blk * 16 + w : DFF + blk * 16 + (w - 16); }
        float4 v = make_float4(0.f, 0.f, 0.f, 0.f);
        if (sc_ < Nsrc) v = *(const float4*)(src + (size_t)(kt * 64 + kk) * Nsrc + sc_);
        t[kk * 65 + nn] = v.x; t[kk * 65 + nn + 1] = v.y; t[kk * 65 + nn + 2] = v.z; t[kk * 65 + nn + 3] = v.w;
      }
    }
    __syncthreads();
#pragma unroll 1
    for (int q = 0; q < 4; ++q) {
      const float* src; int K, Nsrc, kt, nt; u16* dst; bool perm;
      conv_decode(p, l, g * 4 + q, src, K, Nsrc, dst, kt, nt, perm);
      const float* t = tb + q * (64 * 65);
#pragma unroll
      for (int i = 0; i < 4; ++i) {
        int e = tid + i * NTH; int nn = e >> 5, kp = e & 31;
        unsigned v = pack2(t[(2 * kp) * 65 + nn], t[(2 * kp + 1) * 65 + nn]);
        *(unsigned*)(dst + (size_t)(nt * 64 + nn) * K + kt * 64 + 2 * kp) = v;
      }
    }
  }
  __syncthreads();
}

DEV void init_phase(const Params& p) {
  const int TIDX = ltid();
  const float* MOD = (const float*)(p.ws + WS_MOD);
  float4* X4 = (float4*)(p.ws + WS_X);
  u16* H = (u16*)(p.ws + WS_H);
  const size_t n4 = (size_t)MTOT * 256;
  for (size_t e = (size_t)blockIdx.x * NTH + TIDX; e < n4; e += (size_t)gridDim.x * NTH) {
    int row = (int)(e >> 8), c = (int)(e & 255) * 4;
    float4 v = (row < MP) ? ((const float4*)p.in[0])[e] : ((const float4*)p.in[1])[e - (size_t)MP * 256];
    X4[e] = v;
    const float* mo = MOD + row_mi(row) * 9216;
    float4 sh = *(const float4*)(mo + c), scl = *(const float4*)(mo + 1024 + c);
    uint2 o;
    o.x = pack2(v.x * (1.f + scl.x) + sh.x, v.y * (1.f + scl.y) + sh.y);
    o.y = pack2(v.z * (1.f + scl.z) + sh.z, v.w * (1.f + scl.w) + sh.w);
    *(uint2*)(H + (size_t)row * 1024 + c) = o;
  }
}

DEV void ln_phase(const Params& p, int l, int sub) {
  const int TIDX = ltid();
  const float* MOD = (const float*)(p.ws + WS_MOD);
  const float* g = p.in[12] + (l * 3 + sub) * 1024;
  const float* bb = p.in[13] + (l * 3 + sub) * 1024;
  const bool fin = (l == 1 && sub == 2);
  const int nl = sub < 2 ? l : l + 1, ns = sub < 2 ? sub + 1 : 0;
  float* X = (float*)(p.ws + WS_X);
  u16* H = (u16*)(p.ws + WS_H);
  const int lane = TIDX & 63, wave = TIDX >> 6;
  for (int grp = blockIdx.x * 8 + wave; grp < MTOT / 8; grp += gridDim.x * 8) {
    const int row0 = grp * 8;
    const float* mo = MOD + (nl * 3 + row_mi(row0)) * 9216 + ns * 3072;
    float4 gg[4], b4[4], sh[4], scl[4];
#pragma unroll
    for (int i = 0; i < 4; ++i) {
      const int c = i * 256 + lane * 4;
      gg[i] = *(const float4*)(g + c); b4[i] = *(const float4*)(bb + c);
      if (!fin) { sh[i] = *(const float4*)(mo + c); scl[i] = *(const float4*)(mo + 1024 + c); }
      else { sh[i] = make_float4(0.f, 0.f, 0.f, 0.f); scl[i] = sh[i]; }
    }
#pragma unroll 2
    for (int r = 0; r < 8; ++r) {
      const int row = row0 + r;
      float4 v[4];
      float s = 0.f;
#pragma unroll
      for (int i = 0; i < 4; ++i) { v[i] = *(const float4*)(X + (size_t)row * 1024 + i * 256 + lane * 4); s += v[i].x + v[i].y + v[i].z + v[i].w; }
      float mean = wave_sum(s) * (1.f / 1024.f);
      float q = 0.f;
#pragma unroll
      for (int i = 0; i < 4; ++i) {
        v[i].x -= mean; v[i].y -= mean; v[i].z -= mean; v[i].w -= mean;
        q += v[i].x * v[i].x + v[i].y * v[i].y + v[i].z * v[i].z + v[i].w * v[i].w;
      }
      float rs = rsqrtf(wave_sum(q) * (1.f / 1024.f) + EPS_F);
#pragma unroll
      for (int i = 0; i < 4; ++i) {
        int c = i * 256 + lane * 4;
        float4 y;
        y.x = v[i].x * rs * gg[i].x + b4[i].x; y.y = v[i].y * rs * gg[i].y + b4[i].y;
        y.z = v[i].z * rs * gg[i].z + b4[i].z; y.w = v[i].w * rs * gg[i].w + b4[i].w;
        if (fin) {
          *(float4*)(p.out + (size_t)row * 1024 + c) = y;
        } else {
          *(float4*)(X + (size_t)row * 1024 + c) = y;
          uint2 o;
          o.x = pack2(y.x * (1.f + scl[i].x) + sh[i].x, y.y * (1.f + scl[i].y) + sh[i].y);
          o.y = pack2(y.z * (1.f + scl[i].z) + sh[i].z, y.w * (1.f + scl[i].w) + sh[i].w);
          *(uint2*)(H + (size_t)row * 1024 + c) = o;
        }
      }
    }
  }
}

constexpr int BM = 256, BK = 64, HALF = 128, NXCD = 8, WGM = 8, HT = HALF * BK;
DEV int lds_byte(int r, int c) {
  int st = (r >> 4) * 2 + (c >> 5), rr = r & 15, cc = c & 31, ob = rr * 64 + cc * 2;
  return st * 1024 + (ob ^ (((ob >> 9) & 1) << 5));
}
DEV void stage_rc(int b, int& R, int& C) {
  int st = b / 1024, sb = b % 1024, swz = sb ^ (((sb >> 9) & 1) << 5);
  R = (st >> 1) * 16 + swz / 64; C = (st & 1) * 32 + (swz % 64) / 2;
}
enum { EPI_SWIGLU = 0, EPI_RESID = 1, EPI_PROJ = 2 };

template <int EPI>
DEV void gemm_phase(size_t offA, size_t offB, int M, int N, int K, size_t offGate, float gscale) {
  const int TIDX = ltid();
  const u16* A; const u16* Bt;
  { Params p0 = getp(); A = (const u16*)(p0.ws + offA); Bt = (const u16*)(p0.ws + offB); }
  extern __shared__ __attribute__((aligned(16))) u16 shm[];
#define SA(b, h) (shm + ((b) * 2 + (h)) * HT)
#define SB(b, h) (shm + (4 + (b) * 2 + (h)) * HT)
#define STAGE(P, BASE, br, kt) do { const int _so = ((br) * K + (kt) * BK) * 2; \
    __builtin_amdgcn_raw_ptr_buffer_load_lds(rs##BASE, (__attribute__((address_space(3))) void*)((char*)(P) + TIDX * 16), 16, toff0, _so, 0, 0); \
    __builtin_amdgcn_raw_ptr_buffer_load_lds(rs##BASE, (__attribute__((address_space(3))) void*)((char*)(P) + TIDX * 16 + 8192), 16, toff0, _so + K * 128, 0, 0); } while (0)
#define LDA(dst, b, h) for (int m = 0; m < 4; ++m) for (int k = 0; k < 2; ++k) \
    dst[m][k] = *reinterpret_cast<const bf16x8*>((char*)SA(b, h) + lds_byte(wr * 64 + m * 16 + fr, k * 32 + fq * 8))
#define LDB(dst, b, h) for (int n = 0; n < 2; ++n) for (int k = 0; k < 2; ++k) \
    dst[n][k] = *reinterpret_cast<const bf16x8*>((char*)SB(b, h) + lds_byte(wc * 32 + n * 16 + fr, k * 32 + fq * 8))
#define MMA(ai, bj, At, Bt_) do { __builtin_amdgcn_s_setprio(1); \
    for (int m = 0; m < 4; ++m) for (int n = 0; n < 2; ++n) for (int k = 0; k < 2; ++k) \
      acc[ai][bj][m][n] = __builtin_amdgcn_mfma_f32_16x16x32_bf16(At[m][k], Bt_[n][k], acc[ai][bj][m][n], 0, 0, 0); \
    __builtin_amdgcn_s_setprio(0); } while (0)
#define WAIT_V(n) asm volatile("s_waitcnt vmcnt(" #n ")" ::: "memory")
#define WAIT_L(n) asm volatile("s_waitcnt lgkmcnt(" #n ")" ::: "memory")
#define BAR __builtin_amdgcn_s_barrier()
#define SCHED __builtin_amdgcn_sched_barrier(0)

  const int nM = M / BM, nN = N / BM, nwg = nM * nN;
  const int wid = __builtin_amdgcn_readfirstlane(TIDX >> 6), lane = TIDX & 63, wr = wid >> 2, wc = wid & 3, fr = lane & 15, fq = lane >> 4;
  const int nt = K / BK;
  int toff0;
  { int _r, _c; stage_rc(TIDX * 16, _r, _c); toff0 = (_r * K + _c) * 2; }
  const __amdgpu_buffer_rsrc_t rsA = __builtin_amdgcn_make_buffer_rsrc((void*)A, 0, 0x7ffffff0, 0x00020000);
  const __amdgpu_buffer_rsrc_t rsBt = __builtin_amdgcn_make_buffer_rsrc((void*)Bt, 0, 0x7ffffff0, 0x00020000);
  for (int vt = blockIdx.x; vt < nwg; vt += gridDim.x) {
    int wgid = vt;
    { int q = nwg / NXCD, r = nwg % NXCD, xcd = wgid % NXCD, off = wgid / NXCD;
      wgid = (xcd < r ? xcd * (q + 1) : r * (q + 1) + (xcd - r) * q) + off; }
    int nig = WGM * nN, gid = wgid / nig, fm = gid * WGM, gsz = min(nM - fm, WGM);
    int pm = fm + ((wgid % nig) % gsz), pn = (wgid % nig) / gsz, brow = pm * BM, bcol = pn * BM;
    f32x4 acc[2][2][4][2] = {};
    bf16x8 At[4][2], B0[2][2], B1[2][2];
    __syncthreads();
    STAGE(SB(0, 0), Bt, bcol, 0); STAGE(SA(0, 0), A, brow, 0);
    STAGE(SB(0, 1), Bt, bcol + HALF, 0); STAGE(SA(0, 1), A, brow + HALF, 0);
    if (wr == 1) BAR;
    WAIT_V(4); BAR;
    STAGE(SB(1, 0), Bt, bcol, 1); STAGE(SA(1, 0), A, brow, 1); STAGE(SB(1, 1), Bt, bcol + HALF, 1);
    WAIT_V(6); BAR;
    for (int t = 0; t < nt - 2; t += 2) {
      LDB(B0, 0, 0); SCHED; LDA(At, 0, 0); STAGE(SA(1, 1), A, brow + HALF, t + 1);
      WAIT_L(8); BAR; WAIT_L(0); MMA(0, 0, At, B0); BAR; SCHED;
      LDB(B1, 0, 1); STAGE(SB(0, 0), Bt, bcol, t + 2);
      BAR; WAIT_L(0); MMA(0, 1, At, B1); BAR;
      LDA(At, 0, 1); STAGE(SA(0, 0), A, brow, t + 2);
      BAR; WAIT_L(0); MMA(1, 0, At, B0); BAR; SCHED;
      STAGE(SB(0, 1), Bt, bcol + HALF, t + 2);
      WAIT_V(6); BAR; MMA(1, 1, At, B1); BAR;
      LDB(B0, 1, 0); SCHED; LDA(At, 1, 0); STAGE(SA(0, 1), A, brow + HALF, t + 2);
      WAIT_L(8); BAR; WAIT_L(0); MMA(0, 0, At, B0); BAR; SCHED;
      LDB(B1, 1, 1); STAGE(SB(1, 0), Bt, bcol, t + 3);
      BAR; WAIT_L(0); MMA(0, 1, At, B1); BAR;
      LDA(At, 1, 1); STAGE(SA(1, 0), A, brow, t + 3);
      BAR; WAIT_L(0); MMA(1, 0, At, B0); BAR; SCHED;
      STAGE(SB(1, 1), Bt, bcol + HALF, t + 3);
      WAIT_V(6); BAR; MMA(1, 1, At, B1); BAR;
    }
    { LDB(B0, 0, 0); LDA(At, 0, 0); STAGE(SA(1, 1), A, brow + HALF, nt - 1);
      BAR; WAIT_L(0); MMA(0, 0, At, B0); BAR;
      LDB(B1, 0, 1); BAR; WAIT_L(0); MMA(0, 1, At, B1); BAR;
      LDA(At, 0, 1); WAIT_V(4); BAR; WAIT_L(0); MMA(1, 0, At, B0); MMA(1, 1, At, B1); BAR; }
    { LDB(B0, 1, 0); LDA(At, 1, 0); WAIT_V(2); BAR; WAIT_L(0); MMA(0, 0, At, B0); BAR;
      LDB(B1, 1, 1); WAIT_V(0); BAR; WAIT_L(0); MMA(0, 1, At, B1); BAR;
      LDA(At, 1, 1); BAR; WAIT_L(0); MMA(1, 0, At, B0); MMA(1, 1, At, B1); BAR; }
    if (wr == 0) BAR;
    const int mi = row_mi(brow);
    Params p1 = getp();
    float* Xres = (float*)(p1.ws + WS_X);
    const float* gate = (const float*)(p1.ws + WS_MOD) + offGate;
    u16* outb = (u16*)(p1.ws + WS_R1);
    float gsc[2][2];
    if (EPI == EPI_RESID) {
#pragma unroll
      for (int bj = 0; bj < 2; ++bj)
#pragma unroll
        for (int n = 0; n < 2; ++n) gsc[bj][n] = gscale * gate[mi * 9216 + bcol + bj * HALF + wc * 32 + n * 16 + fr];
    }
#pragma unroll
    for (int ai = 0; ai < 2; ++ai)
#pragma unroll
      for (int bj = 0; bj < 2; ++bj)
#pragma unroll
        for (int m = 0; m < 4; ++m)
#pragma unroll
          for (int j = 0; j < 4; ++j) {
            const int row = brow + ai * HALF + wr * 64 + m * 16 + fq * 4 + j;
            const int cb = bcol + bj * HALF + wc * 32;
            if (EPI == EPI_SWIGLU) {
              float gv = acc[ai][bj][m][0][j], uv = acc[ai][bj][m][1][j];
              outb[(size_t)row * DFF + (cb >> 1) + fr] = f2bf(siluf(gv) * uv);
            } else if (EPI == EPI_RESID) {
#pragma unroll
              for (int n = 0; n < 2; ++n) {
                int col = cb + n * 16 + fr;
                size_t ix = (size_t)row * DM + col;
                Xres[ix] = ALPHA_F * Xres[ix] + gsc[bj][n] * acc[ai][bj][m][n][j];
              }
            } else {
#pragma unroll
              for (int n = 0; n < 2; ++n) outb[(size_t)row * NINP + cb + n * 16 + fr] = f2bf(acc[ai][bj][m][n][j]);
            }
          }
  }
  __syncthreads();
}

DEV void rope_cs(int pos, int fi, float nfreq, float& c, float& s) {
  float inv = exp2f(-(float)fi / nfreq * 13.287712379549449f);
  __sincosf((float)pos * inv, &s, &c);
}

DEV void prep_phase(const Params& p, int l) {
  const int TIDX = ltid();
  LDS_DECL;
  float* raw = (float*)lds_raw;
  const int tid = TIDX, lane = tid & 63, wave = tid >> 6;
  const u16* PROJ = (const u16*)(p.ws + WS_R1);
  u16* QA = (u16*)(p.ws + WS_QA); u16* KA = (u16*)(p.ws + WS_KA); u16* VA = (u16*)(p.ws + WS_VA);
  u16* QD = (u16*)(p.ws + WS_QD); u16* KD = (u16*)(p.ws + WS_KD);
  const float* wuq = p.in[20] + (size_t)l * 192 * 384;
  const float* wukv = p.in[21] + (size_t)l * 128 * 512;
  const float* gq = p.in[18] + l * 192;
  const float* gkv = p.in[19] + l * 128;
  const float qsA = 0.10206207261596577f * LOG2E;
  const float qsD = 0.125f * LOG2E;
  for (int u = blockIdx.x; u < 544; u += gridDim.x) {
    const bool cache = u >= 512;
    int row0 = 0, cb = 0, cpos0 = 0;
    if (!cache) row0 = u * 32; else { cb = (u - 512) >> 4; cpos0 = ((u - 512) & 15) * 32; }
    const bool lat = cache || row0 >= MP;
    __syncthreads();
    if (!cache) {
      for (int e = tid; e < 32 * 44; e += NTH) {
        int r = e / 44, c = (e % 44) * 8;
        uint4 v = *(const uint4*)(PROJ + (size_t)(row0 + r) * NINP + c);
        float* d = raw + r * 352 + c;
        d[0] = bf2f(v.x & 0xffff); d[1] = bf2f(v.x >> 16); d[2] = bf2f(v.y & 0xffff); d[3] = bf2f(v.y >> 16);
        d[4] = bf2f(v.z & 0xffff); d[5] = bf2f(v.z >> 16); d[6] = bf2f(v.w & 0xffff); d[7] = bf2f(v.w >> 16);
      }
    } else {
      const float* ck = p.in[2] + ((size_t)(cb * 2 + l) * 512 + cpos0) * 128;
      const float* cr = p.in[3] + ((size_t)(cb * 2 + l) * 512 + cpos0) * 32;
      for (int e = tid; e < 32 * 128; e += NTH) raw[(e >> 7) * 352 + 192 + (e & 127)] = ck[e];
      for (int e = tid; e < 32 * 32; e += NTH) raw[(e >> 5) * 352 + 320 + (e & 31)] = cr[e];
    }
    __syncthreads();
    if (!cache) {
      for (int tsk = wave; tsk < 64; tsk += 8) {
        int r = tsk >> 1, which = tsk & 1;
        float* x = raw + r * 352 + (which ? 192 : 0);
        int n = which ? 128 : 192;
        float s = 0.f;
        for (int k = lane; k < n; k += 64) s += x[k] * x[k];
        float rs = rsqrtf(wave_sum(s) / (float)n + EPS_F);
        const float* gg = which ? gkv : gq;
        for (int k = lane; k < n; k += 64) x[k] = x[k] * rs * gg[k];
      }
    }
    __syncthreads();
    if (!cache && !lat) {
      int b = row0 >> 8, t0 = row0 & 255;
      for (int e = tid; e < 32 * 128; e += NTH) {
        int r = e >> 7, c = e & 127;
        size_t ob = ((size_t)(b * 2 + l) * 256 + t0 + r);
        p.out[O_CKV + ob * 128 + c] = raw[r * 352 + 192 + c];
        p.out[O_DK + ob * 128 + c] = bf2f(PROJ[(size_t)(row0 + r) * NINP + C_DK + c]);
        p.out[O_DV + ob * 128 + c] = bf2f(PROJ[(size_t)(row0 + r) * NINP + C_DV + c]);
      }
      for (int e = tid; e < 32 * 32; e += NTH) {
        int r = e >> 5, c = e & 31;
        p.out[O_KR + ((size_t)(b * 2 + l) * 256 + t0 + r) * 32 + c] = raw[r * 352 + 320 + c];
      }
    }
    {
      constexpr int XP = 328;
      u16* xa = (u16*)(raw + 32 * 352);
      for (int e = TIDX; e < 32 * 160; e += NTH) {
        int r = e / 160, k2 = (e % 160) * 2;
        *(unsigned*)(xa + r * XP + k2) = pack2(raw[r * 352 + k2], raw[r * 352 + k2 + 1]);
      }
      __syncthreads();
      const int fr = lane & 15, fq = lane >> 4;
      const u16* WUQ = (const u16*)(p.ws + WS_WUQ);
      const u16* WUKV = (const u16*)(p.ws + WS_WUKV);
#pragma unroll 1
      for (int ct = wave; ct < 56; ct += 8) {
        const bool isq = ct < 24;
        if (isq && cache) continue;
        const int Kd = isq ? 192 : 128, nks = Kd >> 5, koff = isq ? 0 : 192;
        const u16* wrow = isq ? (WUQ + (size_t)(ct * 16 + fr) * 192) : (WUKV + (size_t)((ct - 24) * 16 + fr) * 128);
        bf16x8 bfr[6];
#pragma unroll
        for (int ks = 0; ks < 6; ++ks) bfr[ks] = (ks < nks) ? *(const bf16x8*)(wrow + ks * 32 + fq * 8) : bfr[0];
        f32x4 acc2[2];
        acc2[0] = (f32x4){0.f, 0.f, 0.f, 0.f}; acc2[1] = acc2[0];
#pragma unroll
        for (int ks = 0; ks < 6; ++ks) {
          if (ks < nks) {
#pragma unroll
            for (int rt = 0; rt < 2; ++rt) {
              bf16x8 av = *(const bf16x8*)(xa + (rt * 16 + fr) * XP + koff + ks * 32 + fq * 8);
              acc2[rt] = __builtin_amdgcn_mfma_f32_16x16x32_bf16(av, bfr[ks], acc2[rt], 0, 0, 0);
            }
          }
        }
        const int c = ct * 16 + fr;
        if (isq) {
          const int d = c % 96;
          const bool rp = lat && d >= 64;
          const int dd = d - 64;
          const int ax = (dd >> 4) & 1, i16 = dd & 15, fi = i16 & 7;
#pragma unroll
          for (int rt = 0; rt < 2; ++rt)
#pragma unroll
            for (int r = 0; r < 4; ++r) {
              const int rl = rt * 16 + fq * 4 + r;
              const float self = acc2[rt][r];
              float other = __shfl_xor(self, 8);
              float val = self;
              if (rp) {
                int t = (row0 + rl - MP) & 4095;
                int pos = ax ? (t & 63) : (t >> 6);
                float cs, sn; rope_cs(pos, fi, 8.f, cs, sn);
                val = (i16 < 8) ? (self * cs - other * sn) : (other * sn + self * cs);
              }
              QA[(size_t)(row0 + rl) * 384 + c] = f2bf(val * qsA);
            }
        } else {
          const int cc = c - 384, h = cc >> 7, d = cc & 127;
#pragma unroll
          for (int rt = 0; rt < 2; ++rt)
#pragma unroll
            for (int r = 0; r < 4; ++r) {
              const int rl = rt * 16 + fq * 4 + r;
              const float self = acc2[rt][r];
              size_t krow;
              if (cache) krow = 8192 + (size_t)cb * 4608 + 4096 + cpos0 + rl;
              else if (!lat) krow = row0 + rl;
              else { int rr = row0 + rl - MP; krow = 8192 + (size_t)(rr >> 12) * 4608 + (rr & 4095); }
              if (d < 64) KA[krow * 384 + h * 96 + d] = f2bf(self);
              else VA[krow * 256 + h * 64 + (d - 64)] = f2bf(self);
            }
        }
      }
    }
    for (int e = tid; e < 32 * 32; e += NTH) {
      int r = e >> 5, j = e & 31;
      float val = raw[r * 352 + 320 + j];
      size_t krow;
      if (cache) krow = 8192 + (size_t)cb * 4608 + 4096 + cpos0 + r;
      else if (!lat) krow = row0 + r;
      else {
        int rr = row0 + r - MP; krow = 8192 + (size_t)(rr >> 12) * 4608 + (rr & 4095);
        int t = rr & 4095;
        int ax = j >> 4, i16 = j & 15, fi = i16 & 7;
        int pos = ax ? (t & 63) : (t >> 6);
        float cs, sn; rope_cs(pos, fi, 8.f, cs, sn);
        float other = raw[r * 352 + 320 + (j ^ 8)];
        val = (i16 < 8) ? (val * cs - other * sn) : (other * sn + val * cs);
      }
      u16 bv = f2bf(val);
#pragma unroll
      for (int h = 0; h < 4; ++h) KA[krow * 384 + h * 96 + 64 + j] = bv;
    }
    if (!cache) {
      for (int e = tid; e < 32 * 384; e += NTH) {
        int r = e / 384, c = e % 384;
        int row = row0 + r;
        const u16* src = PROJ + (size_t)row * NINP + (c < 256 ? C_DQ + c : C_DK + (c - 256));
        float val = bf2f(src[0]);
        if (lat) {
          int d = c & 63;
          int ax = d >> 5, i32 = d & 31, fi = i32 & 15;
          int t = (row - MP) & 4095;
          int pos = ax ? (t & 63) : (t >> 6);
          float cs, sn; rope_cs(pos, fi, 16.f, cs, sn);
          float other = bf2f((i32 < 16) ? src[16] : src[-16]);
          val = (i32 < 16) ? (val * cs - other * sn) : (other * sn + val * cs);
        }
        if (c < 256) QD[(size_t)row * 256 + c] = f2bf(val * qsD);
        else KD[(size_t)row * 128 + (c - 256)] = f2bf(val);
      }
    }
  }
  __syncthreads();
}

DEV bf16x8 mk8(unsigned a, unsigned b, unsigned c, unsigned d) {
  union { unsigned u[4]; bf16x8 v; } x; x.u[0] = a; x.u[1] = b; x.u[2] = c; x.u[3] = d; return x.v;
}
template <int DQK>
DEV void attn_seg(u16* Ks, u16* Vt, const void* kb, int kst, const void* vb, int vst, bool f32src,
                  int nkeys, int keypos0, bool masked, int qpos,
                  const bf16x8 (&qf)[2][DQK / 32], f32x4 (&o)[2][4], float (&m)[2], float (&l)[2]) {
  const int TIDX = ltid();
  constexpr int KP = DQK + 8, VP = 72;
  const int tid = TIDX, lane = tid & 63, fr = lane & 15, fq = lane >> 4;
  constexpr int NKC = 64 * DQK / 8;
  const int e1 = tid + NTH;
  const int kkey0 = tid / (DQK / 8), kc0 = (tid % (DQK / 8)) * 8;
  const int kkey1 = e1 / (DQK / 8), kc1 = (e1 % (DQK / 8)) * 8;
  const bool has1 = e1 < NKC;
  const int vkey = tid >> 3, vc = (tid & 7) * 8;
  uint4 rk0 = make_uint4(0, 0, 0, 0), rk1 = make_uint4(0, 0, 0, 0), rv = make_uint4(0, 0, 0, 0);
  if (!f32src) {
    rk0 = *(const uint4*)((const u16*)kb + (size_t)kkey0 * kst + kc0);
    if (has1) rk1 = *(const uint4*)((const u16*)kb + (size_t)kkey1 * kst + kc1);
    rv = *(const uint4*)((const u16*)vb + (size_t)vkey * vst + vc);
  }
  for (int k0 = 0; k0 < nkeys; k0 += 64) {
    __syncthreads();
    if (!f32src) {
      *(uint4*)(Ks + kkey0 * KP + kc0) = rk0;
      if (has1) *(uint4*)(Ks + kkey1 * KP + kc1) = rk1;
      Vt[(vc + 0) * VP + vkey] = (u16)(rv.x & 0xffff); Vt[(vc + 1) * VP + vkey] = (u16)(rv.x >> 16);
      Vt[(vc + 2) * VP + vkey] = (u16)(rv.y & 0xffff); Vt[(vc + 3) * VP + vkey] = (u16)(rv.y >> 16);
      Vt[(vc + 4) * VP + vkey] = (u16)(rv.z & 0xffff); Vt[(vc + 5) * VP + vkey] = (u16)(rv.z >> 16);
      Vt[(vc + 6) * VP + vkey] = (u16)(rv.w & 0xffff); Vt[(vc + 7) * VP + vkey] = (u16)(rv.w >> 16);
      if (k0 + 64 < nkeys) {
        const int kn = k0 + 64;
        rk0 = *(const uint4*)((const u16*)kb + (size_t)(kn + kkey0) * kst + kc0);
        if (has1) rk1 = *(const uint4*)((const u16*)kb + (size_t)(kn + kkey1) * kst + kc1);
        rv = *(const uint4*)((const u16*)vb + (size_t)(kn + vkey) * vst + vc);
      }
    } else {
      for (int e = tid; e < 64 * 16; e += NTH) {
        int key = e >> 4, c = (e & 15) * 4;
        float4 v = *(const float4*)((const float*)kb + (size_t)(k0 + key) * kst + c);
        uint2 w; w.x = pack2(v.x, v.y); w.y = pack2(v.z, v.w);
        *(uint2*)(Ks + key * KP + c) = w;
        float4 x = *(const float4*)((const float*)vb + (size_t)(k0 + key) * vst + c);
        Vt[(c + 0) * VP + key] = f2bf(x.x); Vt[(c + 1) * VP + key] = f2bf(x.y);
        Vt[(c + 2) * VP + key] = f2bf(x.z); Vt[(c + 3) * VP + key] = f2bf(x.w);
      }
    }
    __syncthreads();
    f32x4 s[2][4];
#pragma unroll
    for (int kt = 0; kt < 4; ++kt) {
      s[0][kt] = (f32x4){0.f, 0.f, 0.f, 0.f}; s[1][kt] = s[0][kt];
#pragma unroll
      for (int ks = 0; ks < DQK / 32; ++ks) {
        bf16x8 a = *(const bf16x8*)(Ks + (kt * 16 + fr) * KP + ks * 32 + fq * 8);
        s[0][kt] = __builtin_amdgcn_mfma_f32_16x16x32_bf16(a, qf[0][ks], s[0][kt], 0, 0, 0);
        s[1][kt] = __builtin_amdgcn_mfma_f32_16x16x32_bf16(a, qf[1][ks], s[1][kt], 0, 0, 0);
      }
    }
#pragma unroll
    for (int qt = 0; qt < 2; ++qt) {
      if (masked) {
#pragma unroll
        for (int kt = 0; kt < 4; ++kt)
#pragma unroll
          for (int r = 0; r < 4; ++r) {
            int df = keypos0 + k0 + kt * 16 + fq * 4 + r - (qpos + qt * 16);
            if (df > 128 || df < -128) s[qt][kt][r] = -INFINITY;
          }
      }
      float mx = m[qt];
#pragma unroll
      for (int kt = 0; kt < 4; ++kt)
#pragma unroll
        for (int r = 0; r < 4; ++r) mx = fmaxf(mx, s[qt][kt][r]);
      mx = fmaxf(mx, __shfl_xor(mx, 16));
      mx = fmaxf(mx, __shfl_xor(mx, 32));
      float alpha = __builtin_amdgcn_exp2f(m[qt] - mx);
      m[qt] = mx;
      float rs = 0.f;
#pragma unroll
      for (int kt = 0; kt < 4; ++kt)
#pragma unroll
        for (int r = 0; r < 4; ++r) { float pv = __builtin_amdgcn_exp2f(s[qt][kt][r] - mx); s[qt][kt][r] = pv; rs += pv; }
      rs += __shfl_xor(rs, 16);
      rs += __shfl_xor(rs, 32);
      l[qt] = l[qt] * alpha + rs;
#pragma unroll
      for (int dt = 0; dt < 4; ++dt) { o[qt][dt][0] *= alpha; o[qt][dt][1] *= alpha; o[qt][dt][2] *= alpha; o[qt][dt][3] *= alpha; }
    }
#pragma unroll
    for (int s2 = 0; s2 < 2; ++s2) {
      bf16x8 pb0 = mk8(pack2(s[0][2 * s2][0], s[0][2 * s2][1]), pack2(s[0][2 * s2][2], s[0][2 * s2][3]),
                       pack2(s[0][2 * s2 + 1][0], s[0][2 * s2 + 1][1]), pack2(s[0][2 * s2 + 1][2], s[0][2 * s2 + 1][3]));
      bf16x8 pb1 = mk8(pack2(s[1][2 * s2][0], s[1][2 * s2][1]), pack2(s[1][2 * s2][2], s[1][2 * s2][3]),
                       pack2(s[1][2 * s2 + 1][0], s[1][2 * s2 + 1][1]), pack2(s[1][2 * s2 + 1][2], s[1][2 * s2 + 1][3]));
#pragma unroll
      for (int dt = 0; dt < 4; ++dt) {
        const u16* vr = Vt + (dt * 16 + fr) * VP + s2 * 32 + fq * 4;
        uint2 v0 = *(const uint2*)vr, v1 = *(const uint2*)(vr + 16);
        bf16x8 a = mk8(v0.x, v0.y, v1.x, v1.y);
        o[0][dt] = __builtin_amdgcn_mfma_f32_16x16x32_bf16(a, pb0, o[0][dt], 0, 0, 0);
        o[1][dt] = __builtin_amdgcn_mfma_f32_16x16x32_bf16(a, pb1, o[1][dt], 0, 0, 0);
      }
    }
  }
}

DEV void attn_store(const f32x4 (&o)[4], float l, u16* outp  ) {
  const int TIDX = ltid();
  const int lane = TIDX & 63, fq = lane >> 4;
  float inv = 1.f / l;
#pragma unroll
  for (int dt = 0; dt < 4; ++dt) {
    uint2 w; w.x = pack2(o[dt][0] * inv, o[dt][1] * inv); w.y = pack2(o[dt][2] * inv, o[dt][3] * inv);
    *(uint2*)(outp + dt * 16 + fq * 4) = w;
  }
}

DEV void attnA_item(const Params& p, int grp, int b, int h, int qb) {
  const int TIDX = ltid();
  LDS_DECL;
  u16* Ks = (u16*)lds_raw; u16* Vt = Ks + 64 * 104;
  const int tid = TIDX, lane = tid & 63, wave = tid >> 6, fr = lane & 15, fq = lane >> 4;
  const u16* QA = (const u16*)(p.ws + WS_QA); const u16* KA = (const u16*)(p.ws + WS_KA); const u16* VA = (const u16*)(p.ws + WS_VA);
  u16* MIX = (u16*)(p.ws + WS_H);
  const int row = (grp ? MP + b * 4096 : b * 256) + qb * 256 + wave * 32 + fr;
  size_t krow0 = grp ? (size_t)8192 + (size_t)b * 4608 : (size_t)b * 256;
  int nk = grp ? 4608 : 256;
  bf16x8 qf[2][3];
#pragma unroll
  for (int qt = 0; qt < 2; ++qt)
#pragma unroll
    for (int ks = 0; ks < 3; ++ks) qf[qt][ks] = *(const bf16x8*)(QA + (size_t)(row + qt * 16) * 384 + h * 96 + ks * 32 + fq * 8);
  f32x4 o[2][4];
#pragma unroll
  for (int qt = 0; qt < 2; ++qt)
#pragma unroll
    for (int i = 0; i < 4; ++i) o[qt][i] = (f32x4){0.f, 0.f, 0.f, 0.f};
  float m[2] = {-1e30f, -1e30f}, l[2] = {0.f, 0.f};
  attn_seg<96>(Ks, Vt, KA + krow0 * 384 + h * 96, 384, VA + krow0 * 256 + h * 64, 256, false, nk, 0, false, 0, qf, o, m, l);
  attn_store(o[0], l[0], MIX + (size_t)row * 1024 + h * 64);
  attn_store(o[1], l[1], MIX + (size_t)(row + 16) * 1024 + h * 64);
  __syncthreads();
}

DEV void attnD_item(const Params& p, int l_, int grp, int b, int h, int qb) {
  const int TIDX = ltid();
  LDS_DECL;
  u16* Ks = (u16*)lds_raw; u16* Vt = Ks + 64 * 72;
  const int tid = TIDX, lane = tid & 63, wave = tid >> 6, fr = lane & 15, fq = lane >> 4;
  const u16* QD = (const u16*)(p.ws + WS_QD); const u16* KD = (const u16*)(p.ws + WS_KD);
  const u16* PROJ = (const u16*)(p.ws + WS_R1);
  u16* MIX = (u16*)(p.ws + WS_H);
  const int kvh = h >> 1;
  int rowb = grp ? MP + b * 4096 : b * 256;
  int qloc = qb * 256 + wave * 32 + fr;
  int row = rowb + qloc;
  bf16x8 qf[2][2];
#pragma unroll
  for (int qt = 0; qt < 2; ++qt)
#pragma unroll
    for (int ks = 0; ks < 2; ++ks) qf[qt][ks] = *(const bf16x8*)(QD + (size_t)(row + qt * 16) * 256 + h * 64 + ks * 32 + fq * 8);
  f32x4 o[2][4];
#pragma unroll
  for (int qt = 0; qt < 2; ++qt)
#pragma unroll
    for (int i = 0; i < 4; ++i) o[qt][i] = (f32x4){0.f, 0.f, 0.f, 0.f};
  const float sk = p.in[30][l_ * 4 + h] * LOG2E;
  float m[2] = {sk, sk}, l[2] = {1.f, 1.f};
  if (!grp) {
    attn_seg<64>(Ks, Vt, KD + (size_t)rowb * 128 + kvh * 64, 128, PROJ + (size_t)rowb * NINP + C_DV + kvh * 64, NINP, false,
                 256, 0, false, 0, qf, o, m, l);
  } else {
    int q0 = qb * 256;
    int ks = max(0, q0 - 128), ke = min(4096, q0 + 384);
    attn_seg<64>(Ks, Vt, KD + (size_t)(rowb + ks) * 128 + kvh * 64, 128, PROJ + (size_t)(rowb + ks) * NINP + C_DV + kvh * 64, NINP, false,
                 ke - ks, ks, true, qloc, qf, o, m, l);
    const float* ck = p.in[6] + ((size_t)(b * 2 + l_) * 512) * 128 + kvh * 64;
    const float* cv = p.in[7] + ((size_t)(b * 2 + l_) * 512) * 128 + kvh * 64;
    attn_seg<64>(Ks, Vt, ck, 128, cv, 128, true, 512, 0, false, 0, qf, o, m, l);
  }
  attn_store(o[0], l[0], MIX + (size_t)row * 1024 + 768 + h * 64);
  attn_store(o[1], l[1], MIX + (size_t)(row + 16) * 1024 + 768 + h * 64);
  __syncthreads();
}

DEV void ssd_item(const Params& p, int l, int grp, int b, int h, int mode, int seg) {
  const int TIDX = ltid();
  LDS_DECL;
  const int tid = TIDX, dir = tid >> 8, lt = tid & 255, pp = lt >> 2, nq = lt & 3;
  constexpr int HALF_FLOATS = 3 * 2048 + 32 + (36 * 192) / 2 + 6 * 192 + 32;
  float* base = (float*)lds_raw + dir * HALF_FLOATS;
  float* xs = base; float* Bs = base + 2048; float* Cs = base + 4096; float* dts = base + 6144;
  u16* raw = (u16*)(base + 6144 + 32);
  float* wl = base + 6144 + 32 + (36 * 192) / 2;
  const u16* PROJ = (const u16*)(p.ws + WS_R1);
  float* Yd = (float*)(p.ws + (dir ? WS_YB : WS_YF));
  const int T = grp ? 4096 : 256;
  const int rowb = grp ? MP + b * 4096 : b * 256;
  const int g = h >> 1;
  const float a = -__expf(p.in[24][(l * 2 + dir) * 4 + h]);
  const float dtb = p.in[25][(l * 2 + dir) * 4 + h];
  const float Dk = p.in[26][(l * 2 + dir) * 4 + h];
  const float* cw = p.in[22] + (size_t)l * 5 * 512;
  const float* cbias = p.in[23] + l * 512;
  float S[16];
  float* SLOC = (float*)(p.ws + WS_SSLOC) + ((size_t)((b * 4 + h) * 2 + dir) * NSEG) * 4096 + pp * 64 + nq * 16;
  float* SDEC = (float*)(p.ws + WS_SDEC) + ((b * 4 + h) * 2 + dir) * NSEG;
  if (mode == 2) {
    const float* s0 = p.in[4] + ((((size_t)(b * 2 + l) * 2 + dir) * 4 + h) * 64 + pp) * 64 + nq * 16;
#pragma unroll
    for (int i = 0; i < 16; ++i) S[i] = s0[i];
    const int npre = dir ? NSEG - 1 - seg : seg;
    for (int q = 0; q < npre; ++q) {
      const int sg = dir ? NSEG - 1 - q : q;
      const float dd = SDEC[sg];
      const float* sl = SLOC + (size_t)sg * 4096;
#pragma unroll
      for (int i = 0; i < 16; ++i) S[i] = dd * S[i] + sl[i];
    }
  } else {
#pragma unroll
    for (int i = 0; i < 16; ++i) S[i] = 0.f;
  }
  const int tbeg = (mode == 0) ? 0 : seg * SEGLEN;
  const int tlen = (mode == 0) ? T : SEGLEN;
  float dsum = 0.f;
  __syncthreads();
  for (int e = lt; e < 6 * 192; e += 256) {
    int j = e / 192, ch3 = e % 192, which = ch3 >> 6, cc = ch3 & 63;
    int ch = (which == 0) ? h * 64 + cc : 256 + (which - 1) * 128 + g * 64 + cc;
    wl[e] = (j < 5) ? cw[j * 512 + ch] : cbias[ch];
  }
  const int nch = tlen / 32;
  float* dAs = wl + 6 * 192;
  uint4 pre0, pre1, pre2, pre3;
  float predt = 0.f;
#define SSD_FETCH(ci_) do { \
    const int c_ = dir ? nch - 1 - (ci_) : (ci_); \
    const int t0_ = tbeg + c_ * 32; \
    _Pragma("unroll") \
    for (int i = 0; i < 4; ++i) { \
      const int e = lt + i * 256; \
      uint4 v = make_uint4(0u, 0u, 0u, 0u); \
      if (e < 36 * 24) { \
        int rr = e / 24, q = e % 24, which = q >> 3, c8 = (q & 7) * 8; \
        int t = t0_ + rr - 2; \
        int ch = (which == 0) ? h * 64 + c8 : 256 + (which - 1) * 128 + g * 64 + c8; \
        if (t >= 0 && t < T) v = *(const uint4*)(PROJ + (size_t)(rowb + t) * NINP + C_BXBC + ch); \
      } \
      if (i == 0) pre0 = v; else if (i == 1) pre1 = v; else if (i == 2) pre2 = v; else pre3 = v; \
    } \
    if (lt < 32) predt = bf2f(PROJ[(size_t)(rowb + t0_ + lt) * NINP + C_BDT + dir * 4 + h]); \
  } while (0)
  SSD_FETCH(0);
  for (int ci = 0; ci < nch; ++ci) {
    const int c = dir ? nch - 1 - ci : ci;
    const int t0 = tbeg + c * 32;
    __syncthreads();
#pragma unroll
    for (int i = 0; i < 4; ++i) {
      const int e = lt + i * 256;
      const uint4 pv = (i == 0) ? pre0 : (i == 1) ? pre1 : (i == 2) ? pre2 : pre3;
      if (e < 36 * 24) { int rr = e / 24, q = e % 24; *(uint4*)(raw + rr * 192 + (q >> 3) * 64 + (q & 7) * 8) = pv; }
    }
    if (lt < 32) {
      float x = predt + dtb;
      float dtv = fmaxf(x, 0.f) + log1pf(__expf(-fabsf(x)));
      dts[lt] = dtv;
      dAs[lt] = __expf(dtv * a);
    }
    __syncthreads();
    if (ci + 1 < nch) SSD_FETCH(ci + 1);
    if (lt < 192) {
      const int ch3 = lt, which = ch3 >> 6, cc = ch3 & 63;
      const float w0 = wl[ch3], w1 = wl[192 + ch3], w2 = wl[384 + ch3], w3 = wl[576 + ch3], w4 = wl[768 + ch3], wb = wl[960 + ch3];
      float x0 = bf2f(raw[ch3]), x1 = bf2f(raw[192 + ch3]), x2 = bf2f(raw[384 + ch3]), x3 = bf2f(raw[576 + ch3]);
      float* dst = base + which * 2048 + cc;
#pragma unroll 8
      for (int tt = 0; tt < 32; ++tt) {
        const float x4 = bf2f(raw[(tt + 4) * 192 + ch3]);
        const float accv = wb + w0 * x0 + w1 * x1 + w2 * x2 + w3 * x3 + w4 * x4;
        dst[tt * 64] = siluf(accv);
        x0 = x1; x1 = x2; x2 = x3; x3 = x4;
      }
    }
    __syncthreads();
#pragma unroll 4
    for (int s = 0; s < 32; ++s) {
      const int tt = dir ? 31 - s : s;
      float dtv = dts[tt];
      float dA = dAs[tt];
      float xv = xs[tt * 64 + pp];
      float coef = dtv * xv;
      dsum += dtv;
      if (mode == 1) {
#pragma unroll
        for (int i = 0; i < 16; i += 4) {
          float4 bv = *(const float4*)(Bs + tt * 64 + nq * 16 + i);
          S[i] = dA * S[i] + coef * bv.x; S[i + 1] = dA * S[i + 1] + coef * bv.y;
          S[i + 2] = dA * S[i + 2] + coef * bv.z; S[i + 3] = dA * S[i + 3] + coef * bv.w;
        }
      } else {
        f32x2_t ya = {0.f, 0.f}, yb = {0.f, 0.f};
#pragma unroll
        for (int i = 0; i < 16; i += 4) {
          float4 bv = *(const float4*)(Bs + tt * 64 + nq * 16 + i);
          float4 cv = *(const float4*)(Cs + tt * 64 + nq * 16 + i);
          f32x2_t s01 = {S[i], S[i + 1]}, s23 = {S[i + 2], S[i + 3]};
          f32x2_t b01 = {bv.x, bv.y}, b23 = {bv.z, bv.w}, c01 = {cv.x, cv.y}, c23 = {cv.z, cv.w};
          s01 = dA * s01 + coef * b01; s23 = dA * s23 + coef * b23;
          ya += s01 * c01; yb += s23 * c23;
          S[i] = s01.x; S[i + 1] = s01.y; S[i + 2] = s23.x; S[i + 3] = s23.y;
        }
        float y = (ya.x + ya.y) + (yb.x + yb.y);
        y = quad_sum(y);
        if (nq == 0) Yd[(size_t)(rowb + t0 + tt) * 256 + h * 64 + pp] = y + Dk * xv;
      }
    }
  }
  if (mode == 1) {
    float* sl = SLOC + (size_t)seg * 4096;
#pragma unroll
    for (int i = 0; i < 16; ++i) sl[i] = S[i];
    if (lt == 0) SDEC[seg] = __expf(a * dsum);
  }
  if (mode == 0) {
    float* so = p.out + O_BSSM + ((((size_t)(b * 2 + l) * 2 + dir) * 4 + h) * 64 + pp) * 64 + nq * 16;
#pragma unroll
    for (int i = 0; i < 16; ++i) so[i] = S[i];
  }
  if (mode != 1) {
    asm volatile("s_waitcnt vmcnt(0)" ::: "memory");
    __syncthreads();
    const float* YF = (const float*)(p.ws + WS_YF); const float* YB = (const float*)(p.ws + WS_YB);
    u16* MIX = (u16*)(p.ws + WS_H);
    const int lane = tid & 63, wave = tid >> 6;
    const float gn = p.in[27][l * 256 + h * 64 + lane];
    for (int t0 = tbeg + wave * 4; t0 < tbeg + tlen; t0 += 32) {
      float ya[4], yb[4], zz[4];
#pragma unroll
      for (int u = 0; u < 4; ++u) {
        const size_t row = (size_t)(rowb + t0 + u);
        ya[u] = YF[row * 256 + h * 64 + lane]; yb[u] = YB[row * 256 + h * 64 + lane];
        zz[u] = bf2f(PROJ[row * NINP + C_BZ + h * 64 + lane]);
      }
#pragma unroll
      for (int u = 0; u < 4; ++u) {
        const size_t row = (size_t)(rowb + t0 + u);
        float v = (ya[u] + yb[u]) * siluf(zz[u]);
        float ms = wave_sum(v * v) * (1.f / 64.f);
        MIX[row * 1024 + 256 + h * 64 + lane] = f2bf(v * rsqrtf(ms + EPS_F) * gn);
      }
    }
  }
  __syncthreads();
}

DEV void gla_item(const Params& p, int l, int grp, int b, int h, int mode, int seg) {
  const int TIDX = ltid();
  LDS_DECL;
  const int tid = TIDX, dir = tid >> 8, lt = tid & 255, vv = lt >> 2, kq = lt & 3;
  float* base = (float*)lds_raw + dir * (4 * 2048 + (32 * 192) / 2);
  float* fs = base; float* ks = base + 2048; float* qs = base + 4096; float* vs = base + 6144;
  u16* graw = (u16*)(base + 8192);
  const u16* PROJ = (const u16*)(p.ws + WS_R1);
  float* Od = (float*)(p.ws + (dir ? WS_OB : WS_OF));
  const int T = grp ? 4096 : 256;
  const int rowb = grp ? MP + b * 4096 : b * 256;
  float S[16], Fp[16];
  float* GLOC = (float*)(p.ws + WS_GSLOC) + ((size_t)((b * 4 + h) * 2 + dir) * NSEG) * 4096 + (size_t)(kq * 16) * 64 + vv;
  float* GDEC = (float*)(p.ws + WS_GDEC) + ((size_t)((b * 4 + h) * 2 + dir) * NSEG) * 64 + kq * 16;
#pragma unroll
  for (int i = 0; i < 16; ++i) Fp[i] = 1.f;
  if (mode == 2) {
    const float* s0 = p.in[5] + ((((size_t)(b * 2 + l) * 2 + dir) * 4 + h) * 64) * 64;
#pragma unroll
    for (int i = 0; i < 16; ++i) S[i] = s0[(size_t)(kq * 16 + i) * 64 + vv];
    const int npre = dir ? NSEG - 1 - seg : seg;
    for (int q = 0; q < npre; ++q) {
      const int sg = dir ? NSEG - 1 - q : q;
      const float* sl = GLOC + (size_t)sg * 4096;
      const float* fd = GDEC + sg * 64;
#pragma unroll
      for (int i = 0; i < 16; ++i) S[i] = fd[i] * S[i] + sl[(size_t)i * 64];
    }
  } else {
#pragma unroll
    for (int i = 0; i < 16; ++i) S[i] = 0.f;
  }
  const int tbeg = (mode == 0) ? 0 : seg * SEGLEN;
  const int tlen = (mode == 0) ? T : SEGLEN;
  float lbv = 0.f;
  {
    int k = lt & 63;
    if (l == 1) {
      float l0 = p.in[28][(0 * 2 + dir) * 256 + h * 64 + k], l1 = p.in[28][(1 * 2 + dir) * 256 + h * 64 + k];
      lbv = 1.f / (1.f + __expf(l0 - l1));
    }
  }
  const int nch = tlen / 32;
  uint4 gpre0, gpre1, gpre2;
#define GLA_FETCH(ci_) do { \
    const int c_ = dir ? nch - 1 - (ci_) : (ci_); \
    const int t0_ = tbeg + c_ * 32; \
    _Pragma("unroll") \
    for (int i = 0; i < 3; ++i) { \
      const int e = lt + i * 256; \
      int tt = e / 24, q = e % 24, which = q >> 3, c8 = (q & 7) * 8; \
      int col = (which == 0) ? C_CF + dir * 256 + h * 64 + c8 : (which == 1 ? C_CQ + h * 64 + c8 : C_CI + h * 64 + c8); \
      const uint4 v = *(const uint4*)(PROJ + (size_t)(rowb + t0_ + tt) * NINP + col); \
      if (i == 0) gpre0 = v; else if (i == 1) gpre1 = v; else gpre2 = v; \
    } \
  } while (0)
  GLA_FETCH(0);
  for (int ci = 0; ci < nch; ++ci) {
    const int c = dir ? nch - 1 - ci : ci;
    const int t0 = tbeg + c * 32;
    __syncthreads();
#pragma unroll
    for (int i = 0; i < 3; ++i) {
      const int e = lt + i * 256;
      int tt = e / 24, q = e % 24;
      *(uint4*)(graw + tt * 192 + (q >> 3) * 64 + (q & 7) * 8) = (i == 0) ? gpre0 : (i == 1) ? gpre1 : gpre2;
    }
    __syncthreads();
    if (ci + 1 < nch) GLA_FETCH(ci + 1);
    for (int e = lt; e < 32 * 64; e += 256) {
      int tt = e >> 6, k = e & 63;
      float fr = bf2f(graw[tt * 192 + k]);
      float f = lbv + (1.f - lbv) * sigmf(fr);
      fs[e] = fmaxf(f, 1e-6f);
      ks[e] = (1.f - lbv) * sigmf(-fr);
      qs[e] = bf2f(graw[tt * 192 + 64 + k]);
      vs[e] = bf2f(graw[tt * 192 + 128 + k]);
    }
    __syncthreads();
#pragma unroll 4
    for (int s = 0; s < 32; ++s) {
      const int tt = dir ? 31 - s : s;
      float vt = vs[tt * 64 + vv];
      if (mode == 1) {
#pragma unroll
        for (int i = 0; i < 16; i += 4) {
          float4 f4 = *(const float4*)(fs + tt * 64 + kq * 16 + i);
          float4 k4 = *(const float4*)(ks + tt * 64 + kq * 16 + i);
          S[i] = f4.x * S[i] + k4.x * vt; S[i + 1] = f4.y * S[i + 1] + k4.y * vt;
          S[i + 2] = f4.z * S[i + 2] + k4.z * vt; S[i + 3] = f4.w * S[i + 3] + k4.w * vt;
          Fp[i] *= f4.x; Fp[i + 1] *= f4.y; Fp[i + 2] *= f4.z; Fp[i + 3] *= f4.w;
        }
      } else {
        f32x2_t oa = {0.f, 0.f}, ob2 = {0.f, 0.f};
#pragma unroll
        for (int i = 0; i < 16; i += 4) {
          float4 f4 = *(const float4*)(fs + tt * 64 + kq * 16 + i);
          float4 k4 = *(const float4*)(ks + tt * 64 + kq * 16 + i);
          float4 q4 = *(const float4*)(qs + tt * 64 + kq * 16 + i);
          f32x2_t s01 = {S[i], S[i + 1]}, s23 = {S[i + 2], S[i + 3]};
          f32x2_t f01 = {f4.x, f4.y}, f23 = {f4.z, f4.w}, k01 = {k4.x, k4.y}, k23 = {k4.z, k4.w}, q01 = {q4.x, q4.y}, q23 = {q4.z, q4.w};
          s01 = f01 * s01 + k01 * vt; s23 = f23 * s23 + k23 * vt;
          oa += s01 * q01; ob2 += s23 * q23;
          S[i] = s01.x; S[i + 1] = s01.y; S[i + 2] = s23.x; S[i + 3] = s23.y;
        }
        float o = (oa.x + oa.y) + (ob2.x + ob2.y);
        o = quad_sum(o);
        if (kq == 0) Od[(size_t)(rowb + t0 + tt) * 256 + h * 64 + vv] = o;
      }
    }
  }
  if (mode == 1) {
    float* sl = GLOC + (size_t)seg * 4096;
#pragma unroll
    for (int i = 0; i < 16; ++i) sl[(size_t)i * 64] = S[i];
    if (vv == 0) {
#pragma unroll
      for (int i = 0; i < 16; ++i) GDEC[seg * 64 + i] = Fp[i];
    }
  }
  if (mode == 0) {
    float* so = p.out + O_CH + ((((size_t)(b * 2 + l) * 2 + dir) * 4 + h) * 64) * 64;
#pragma unroll
    for (int i = 0; i < 16; ++i) so[(size_t)(kq * 16 + i) * 64 + vv] = S[i];
  }
  if (mode != 1) {
    asm volatile("s_waitcnt vmcnt(0)" ::: "memory");
    __syncthreads();
    const float* OF = (const float*)(p.ws + WS_OF); const float* OB = (const float*)(p.ws + WS_OB);
    u16* MIX = (u16*)(p.ws + WS_H);
    const int lane = tid & 63, wave = tid >> 6;
    const float gn = p.in[29][l * 256 + h * 64 + lane];
    for (int t0 = tbeg + wave * 4; t0 < tbeg + tlen; t0 += 32) {
      float oa[4], ob[4], gg[4];
#pragma unroll
      for (int u = 0; u < 4; ++u) {
        const size_t row = (size_t)(rowb + t0 + u);
        oa[u] = OF[row * 256 + h * 64 + lane]; ob[u] = OB[row * 256 + h * 64 + lane];
        gg[u] = bf2f(PROJ[row * NINP + C_CG + h * 64 + lane]);
      }
#pragma unroll
      for (int u = 0; u < 4; ++u) {
        const size_t row = (size_t)(rowb + t0 + u);
        float o = oa[u] + ob[u];
        float ms = wave_sum(o * o) * (1.f / 64.f);
        MIX[row * 1024 + 512 + h * 64 + lane] = f2bf(o * rsqrtf(ms + EPS_F) * gn * siluf(gg[u]));
      }
    }
  }
  __syncthreads();
}

DEV void scanA_phase(const Params& p, int l) {
  for (int it = (int)gridDim.x - 1 - (int)blockIdx.x; it < 256; it += gridDim.x) {
    int v = it & 127;
    if (it < 128) ssd_item(p, l, 1, v >> 6, (v >> 4) & 3, 1, v & 15);
    else gla_item(p, l, 1, v >> 6, (v >> 4) & 3, 1, v & 15);
  }
}

DEV void mix_phase(const Params& p, int l) {
  const int TIDX = ltid();
  LDS_DECL;
  unsigned* ctr = (unsigned*)(p.ws + WS_CTL) + l;
  volatile int* slot = (volatile int*)(lds_raw + LDS_BYTES - 16);
  for (;;) {
    __syncthreads();
    if (TIDX == 0) *slot = (int)atomicAdd(ctr, 1u);
    __syncthreads();
    int it = *slot;
    __syncthreads();
    if (it >= 1024) break;
    if (it < 128) attnA_item(p, 1, it >> 6, (it >> 4) & 3, it & 15);
    else if (it < 256) { it -= 128; gla_item(p, l, 1, it >> 6, (it >> 4) & 3, 2, it & 15); }
    else if (it < 384) { it -= 256; ssd_item(p, l, 1, it >> 6, (it >> 4) & 3, 2, it & 15); }
    else if (it < 512) { it -= 384; attnD_item(p, l, 1, it >> 6, (it >> 4) & 3, it & 15); }
    else if (it < 640) { it -= 512; gla_item(p, l, 0, it >> 2, it & 3, 0, 0); }
    else if (it < 768) { it -= 640; ssd_item(p, l, 0, it >> 2, it & 3, 0, 0); }
    else if (it < 896) { it -= 768; attnA_item(p, 0, it >> 2, it & 3, 0); }
    else { it -= 896; attnD_item(p, l, 0, it >> 2, it & 3, 0); }
  }
}

DEV void ffn_gu(int f) { gemm_phase<EPI_SWIGLU>(WS_H, WS_WGU + f * SZ_WGU1, MTOT, NGU, DM, 0, 0.f); }
DEV void ffn_down(int l, int f) { gemm_phase<EPI_RESID>(WS_R1, WS_WDN + f * SZ_WDN1, MTOT, DM, DFF, (size_t)(l * 3 * 9216 + (f ? 2 : 0) * 3072 + 2048), 0.5f); }
DEV void win_gemm() { gemm_phase<EPI_PROJ>(WS_H, WS_WIN, MTOT, NINP, DM, 0, 0.f); }
DEV void wout_gemm(int l) { gemm_phase<EPI_RESID>(WS_H, WS_WOUT, MTOT, DM, DM, (size_t)(l * 3 * 9216 + 1 * 3072 + 2048), 1.0f); }

DEV void finalize_phase(const Params& p, int l) {
  const int TIDX = ltid();
  const int lane = TIDX & 63, wave = TIDX >> 6;
  const u16* PROJ = (const u16*)(p.ws + WS_R1);
  const float* YF = (const float*)(p.ws + WS_YF); const float* YB = (const float*)(p.ws + WS_YB);
  const float* OF = (const float*)(p.ws + WS_OF); const float* OB = (const float*)(p.ws + WS_OB);
  u16* MIX = (u16*)(p.ws + WS_H);
  const int tstride = gridDim.x * 8;
  for (int tsk0 = blockIdx.x * 8 + wave; tsk0 < MTOT * 8; tsk0 += 4 * tstride) {
    float a[4], bq[4], gz[4];
#pragma unroll
    for (int u = 0; u < 4; ++u) {
      const int tsk = tsk0 + u * tstride;
      a[u] = 0.f; bq[u] = 0.f; gz[u] = 0.f;
      if (tsk < MTOT * 8) {
        const size_t row = (size_t)(tsk >> 3);
        const int h = tsk & 3, isC = (tsk >> 2) & 1;
        const float* F = isC ? OF : YF; const float* Bk = isC ? OB : YB;
        a[u] = F[row * 256 + h * 64 + lane]; bq[u] = Bk[row * 256 + h * 64 + lane];
        gz[u] = bf2f(PROJ[row * NINP + (isC ? C_CG : C_BZ) + h * 64 + lane]);
      }
    }
#pragma unroll
    for (int u = 0; u < 4; ++u) {
      const int tsk = tsk0 + u * tstride;
      if (tsk < MTOT * 8) {
        const size_t row = (size_t)(tsk >> 3);
        const int h = tsk & 3, isC = (tsk >> 2) & 1;
        if (!isC) {
          float v = (a[u] + bq[u]) * siluf(gz[u]);
          float ms = wave_sum(v * v) * (1.f / 64.f);
          MIX[row * 1024 + 256 + h * 64 + lane] = f2bf(v * rsqrtf(ms + EPS_F) * p.in[27][l * 256 + h * 64 + lane]);
        } else {
          float o = a[u] + bq[u];
          float ms = wave_sum(o * o) * (1.f / 64.f);
          MIX[row * 1024 + 512 + h * 64 + lane] = f2bf(o * rsqrtf(ms + EPS_F) * p.in[29][l * 256 + h * 64 + lane] * siluf(gz[u]));
        }
      }
    }
  }
}

typedef __attribute__((address_space(1))) unsigned gu32;
struct XcdBar { unsigned xcc, nloc, nx; };
DEV gu32* xb_word(unsigned byteoff) { return (gu32*)(getp().ws + WS_CTL + byteoff); }
DEV unsigned xb_ld(gu32* p) { return __hip_atomic_load(p, __ATOMIC_RELAXED, __HIP_MEMORY_SCOPE_AGENT); }
DEV unsigned xb_add(gu32* p, unsigned v) { return __hip_atomic_fetch_add(p, v, __ATOMIC_RELAXED, __HIP_MEMORY_SCOPE_AGENT); }
constexpr unsigned XB_XCNT = 1024, XB_XSUB = 2048, XB_TOP = 3072, XB_TOPGEN = 3200, XB_XGEN = 3328;
DEV XcdBar xcd_census() {
  LDS_DECL;
  volatile unsigned* st = (volatile unsigned*)(lds_raw + LDS_BYTES - 64);
  XcdBar b;
  if (threadIdx.x == 0) {
    const unsigned xcc = ((unsigned)__builtin_amdgcn_s_getreg((3 << 11) | 20)) & 7u;
    (void)xb_add(xb_word(XB_XCNT + xcc * 128), 1u);
    unsigned sum = 0u, cnt = 0u, mine = 0u;
    for (unsigned sp = 0; sp < (1u << 20); ++sp) {
      sum = 0u; cnt = 0u; mine = 0u;
#pragma unroll
      for (unsigned j = 0; j < 8; ++j) { const unsigned c = xb_ld(xb_word(XB_XCNT + j * 128)); sum += c; cnt += (c > 0u) ? 1u : 0u; mine = (j == xcc) ? c : mine; }
      if (sum == gridDim.x) break;
      __builtin_amdgcn_s_sleep(2);
    }
    st[0] = xcc; st[1] = mine > 0u ? mine : 1u; st[2] = cnt > 0u ? cnt : 1u;
  }
  __syncthreads();
  b.xcc = __builtin_amdgcn_readfirstlane(st[0]);
  b.nloc = __builtin_amdgcn_readfirstlane(st[1]);
  b.nx = __builtin_amdgcn_readfirstlane(st[2]);
  __syncthreads();
  return b;
}
DEV void grid_bar(unsigned& epoch, const XcdBar& b) {
  ++epoch;
  asm volatile("s_waitcnt vmcnt(0)" ::: "memory");
  __syncthreads();
  if (threadIdx.x == 0) {
    __builtin_amdgcn_s_waitcnt(0);
    const unsigned old = xb_add(xb_word(XB_XSUB + b.xcc * 128), 1u);
    if (old + 1u == epoch * b.nloc) {
      __builtin_amdgcn_fence(__ATOMIC_RELEASE, "agent");
      asm volatile("s_waitcnt vmcnt(0)" ::: "memory");
      const unsigned og = xb_add(xb_word(XB_TOP), 1u);
      if (og + 1u == epoch * b.nx) __hip_atomic_store(xb_word(XB_TOPGEN), epoch, __ATOMIC_RELAXED, __HIP_MEMORY_SCOPE_AGENT);
    }
    for (unsigned sp = 0; sp < (1u << 22) && xb_ld(xb_word(XB_TOPGEN)) < epoch; ++sp) __builtin_amdgcn_s_sleep(1);
    __builtin_amdgcn_fence(__ATOMIC_ACQUIRE, "agent");
    asm volatile("s_waitcnt vmcnt(0)" ::: "memory");
  }
  __syncthreads();
}

#ifndef MEGA
#define MEGA 1
#endif
#if MEGA
template <int L>
DEV void layer_body(unsigned& ep, const XcdBar& xb) {
  ffn_gu(0);
  grid_bar(ep, xb);
  ffn_down(L, 0);
  grid_bar(ep, xb);
  ln_phase(getp(), L, 0);
  grid_bar(ep, xb);
  win_gemm();
  grid_bar(ep, xb);
  prep_phase(getp(), L);
  scanA_phase(getp(), L);
  grid_bar(ep, xb);
  mix_phase(getp(), L);
  grid_bar(ep, xb);
  wout_gemm(L);
  grid_bar(ep, xb);
  ln_phase(getp(), L, 1);
  grid_bar(ep, xb);
  ffn_gu(1);
  grid_bar(ep, xb);
  ffn_down(L, 1);
  grid_bar(ep, xb);
  ln_phase(getp(), L, 2);
}

__global__ void __launch_bounds__(NTH) trunk_megakernel(Params pk) {
  cg::grid_group grid = cg::this_grid();
  if (blockIdx.x == 0) { for (int i = threadIdx.x; i < 1024; i += NTH) ((unsigned*)(getp().ws + WS_CTL))[i] = 0u; }
  mod_phase(getp());
  conv_phase(getp(), 0);
  grid.sync();
  const XcdBar xb = xcd_census();
  unsigned ep = 0;
  init_phase(getp());
  grid_bar(ep, xb);
  layer_body<0>(ep, xb);
  conv_phase(getp(), 1);
  grid_bar(ep, xb);
  layer_body<1>(ep, xb);
}

extern "C" void kernel_launch(void* const* d_in, const int* in_sizes, int n_in, void* d_out, int out_size, void* d_ws,
                              size_t ws_size, hipStream_t stream) {
  static int grid_blocks = 0;
  if (!grid_blocks) {
    int dev = 0, cus = 0, per_cu = 0;
    (void)hipGetDevice(&dev);
    (void)hipDeviceGetAttribute(&cus, hipDeviceAttributeMultiprocessorCount, dev);
    (void)hipFuncSetAttribute((const void*)trunk_megakernel, hipFuncAttributeMaxDynamicSharedMemorySize, LDS_BYTES);
    (void)hipOccupancyMaxActiveBlocksPerMultiprocessor(&per_cu, (const void*)trunk_megakernel, NTH, LDS_BYTES);
    if (per_cu < 1) per_cu = 1;
    grid_blocks = cus * per_cu;
    if (ws_size < WS_END) fprintf(stderr, "workspace too small: %zu < %zu\n", ws_size, (size_t)WS_END);
  }
  Params p{};
  for (int i = 0; i < 31; ++i) p.in[i] = (const float*)d_in[i];
  p.out = (float*)d_out;
  p.ws = (unsigned char*)d_ws;
  void* args[] = {&p};
  hipError_t e = hipLaunchCooperativeKernel((const void*)trunk_megakernel, dim3(grid_blocks), dim3(NTH), args, LDS_BYTES, stream);
  if (e != hipSuccess) fprintf(stderr, "cooperative launch failed: %s (grid %d)\n", hipGetErrorString(e), grid_blocks);
}
#else
enum { PH_START = 0, PH_INIT, PH_GU, PH_DOWN, PH_LN, PH_WIN, PH_PREP, PH_MIX, PH_WOUT, PH_CONV1, PH_FIN };
template <int PH, int L, int F>
__global__ void __launch_bounds__(NTH) k_phase(Params pk) {
  if (PH == PH_START) {
    if (blockIdx.x == 0 && threadIdx.x < 16) ((unsigned*)(getp().ws + WS_CTL))[threadIdx.x] = 0u;
    mod_phase(getp());
    conv_phase(getp(), 0);
  } else if (PH == PH_INIT) init_phase(getp());
  else if (PH == PH_GU) ffn_gu(F);
  else if (PH == PH_DOWN) ffn_down(L, F);
  else if (PH == PH_LN) ln_phase(getp(), L, F);
  else if (PH == PH_WIN) win_gemm();
  else if (PH == PH_PREP) { prep_phase(getp(), L); scanA_phase(getp(), L); }
  else if (PH == PH_MIX) mix_phase(getp(), L);
  else if (PH == PH_FIN) finalize_phase(getp(), L);
  else if (PH == PH_WOUT) wout_gemm(L);
  else if (PH == PH_CONV1) conv_phase(getp(), 1);
}
template <int PH, int L, int F>
static void launch_phase(const Params& p, hipStream_t stream) {
  static bool attr = false;
  if (!attr) { (void)hipFuncSetAttribute((const void*)k_phase<PH, L, F>, hipFuncAttributeMaxDynamicSharedMemorySize, LDS_BYTES); attr = true; }
  hipLaunchKernelGGL((k_phase<PH, L, F>), dim3(256), dim3(NTH), LDS_BYTES, stream, p);
}
template <int L>
static void launch_layer(const Params& p, hipStream_t s) {
  launch_phase<PH_GU, L, 0>(p, s);
  launch_phase<PH_DOWN, L, 0>(p, s);
  launch_phase<PH_LN, L, 0>(p, s);
  launch_phase<PH_WIN, L, 0>(p, s);
  launch_phase<PH_PREP, L, 0>(p, s);
  launch_phase<PH_MIX, L, 0>(p, s);
  launch_phase<PH_FIN, L, 0>(p, s);
  launch_phase<PH_WOUT, L, 0>(p, s);
  launch_phase<PH_LN, L, 1>(p, s);
  launch_phase<PH_GU, L, 1>(p, s);
  launch_phase<PH_DOWN, L, 1>(p, s);
  launch_phase<PH_LN, L, 2>(p, s);
}
extern "C" void kernel_launch(void* const* d_in, const int* in_sizes, int n_in, void* d_out, int out_size, void* d_ws,
                              size_t ws_size, hipStream_t stream) {
  if (ws_size < WS_END) fprintf(stderr, "workspace too small: %zu < %zu\n", ws_size, (size_t)WS_END);
  Params p{};
  for (int i = 0; i < 31; ++i) p.in[i] = (const float*)d_in[i];
  p.out = (float*)d_out;
  p.ws = (unsigned char*)d_ws;
  launch_phase<PH_START, 0, 0>(p, stream);
  launch_phase<PH_INIT, 0, 0>(p, stream);
  launch_layer<0>(p, stream);
  launch_phase<PH_CONV1, 0, 0>(p, stream);
  launch_layer<1>(p, stream);
}
#endif
```
